# Optimizing an MI355X kernel written in HIP

```python
import math
import jax
import jax.numpy as jnp
from jax import lax
import numpy as np


D_MODEL = 1024
BATCH = 8
SEQ = 4096
DEPTH = 4

SSM_WIDTH = D_MODEL // 2
SSM_GROUP_WIDTH = 16
N_SSM_GROUPS = SSM_WIDTH // SSM_GROUP_WIDTH
SSM_STATE = 64
HEAD_DIM = 64
N_Q_HEADS = (D_MODEL - SSM_WIDTH) // HEAD_DIM
N_KV_HEADS = 2
GQA_GROUP = N_Q_HEADS // N_KV_HEADS
ATTN_WIDTH = N_Q_HEADS * HEAD_DIM
KV_WIDTH = N_KV_HEADS * HEAD_DIM
IN_WIDTH = SSM_WIDTH + ATTN_WIDTH + 2 * KV_WIDTH
MIX_WIDTH = SSM_WIDTH + ATTN_WIDTH
WINDOW = 128
BLOCK = 128
FFN_HIDDEN = int(math.ceil(8 * D_MODEL / 3 / 256) * 256)
PLE_DIM = 256
RMS_EPS = 1e-6
DT_MIN = 1e-3
DT_MAX = 1e-1

kernel_name = "hymba_s5_swa_sink_hybrid"


def rms_norm(x, g):
    xf = x.astype(jnp.float32)
    y = xf * lax.rsqrt(jnp.mean(xf * xf, axis=-1, keepdims=True) + RMS_EPS)
    return (y * g.astype(jnp.float32)).astype(x.dtype)


def s5_mixer(u, a_re, a_im, log_dt, b_re, b_im, c_re, c_im, d_skip, w_glu):
    bsz, seq, _ = u.shape
    f32 = jnp.float32
    uf = u.astype(f32).reshape(bsz, seq, N_SSM_GROUPS, SSM_GROUP_WIDTH)
    ar = a_re.astype(f32)
    ai = a_im.astype(f32)
    dt = jnp.exp(log_dt.astype(f32))[:, None]
    mag = jnp.exp(ar * dt)
    lb_re = mag * jnp.cos(ai * dt)
    lb_im = mag * jnp.sin(ai * dt)
    den = ar * ar + ai * ai
    nr = lb_re - 1.0
    ni = lb_im
    f_re = (nr * ar + ni * ai) / den
    f_im = (ni * ar - nr * ai) / den
    br = b_re.astype(f32)
    bi = b_im.astype(f32)
    bb_re = f_re[..., None] * br - f_im[..., None] * bi
    bb_im = f_re[..., None] * bi + f_im[..., None] * br
    bu_re = jnp.einsum('blgh,gph->blgp', uf, bb_re)
    bu_im = jnp.einsum('blgh,gph->blgp', uf, bb_im)
    a_t_re = jnp.broadcast_to(lb_re[None, None], (1, seq, N_SSM_GROUPS, SSM_STATE))
    a_t_im = jnp.broadcast_to(lb_im[None, None], (1, seq, N_SSM_GROUPS, SSM_STATE))

    def combine(e1, e2):
        a1r, a1i, b1r, b1i = e1
        a2r, a2i, b2r, b2i = e2
        return (a2r * a1r - a2i * a1i,
                a2r * a1i + a2i * a1r,
                a2r * b1r - a2i * b1i + b2r,
                a2r * b1i + a2i * b1r + b2i)

    _, _, xr, xi = lax.associative_scan(combine, (a_t_re, a_t_im, bu_re, bu_im), axis=1)
    y = (jnp.einsum('blgp,ghp->blgh', xr, c_re.astype(f32))
         - jnp.einsum('blgp,ghp->blgh', xi, c_im.astype(f32)))
    y = y.reshape(bsz, seq, SSM_WIDTH) + d_skip.astype(f32) * uf.reshape(bsz, seq, SSM_WIDTH)
    y = jax.nn.gelu(y)
    y = y * jax.nn.sigmoid(y @ w_glu.astype(f32))
    return y.astype(u.dtype)


def sliding_window_attention(q, k, v, sinks):
    bsz, seq, _, dh = q.shape
    nb = seq // BLOCK
    qb = q.reshape(bsz, nb, BLOCK, N_KV_HEADS, GQA_GROUP, dh)
    kb = k.reshape(bsz, nb, BLOCK, N_KV_HEADS, dh)
    vb = v.reshape(bsz, nb, BLOCK, N_KV_HEADS, dh)
    pad = ((0, 0), (1, 0), (0, 0), (0, 0), (0, 0))
    k_prev = jnp.pad(kb, pad)[:, :-1]
    v_prev = jnp.pad(vb, pad)[:, :-1]
    keys = jnp.concatenate([k_prev, kb], axis=2)
    vals = jnp.concatenate([v_prev, vb], axis=2)
    scale = 1.0 / math.sqrt(dh)
    scores = jnp.einsum('bnqhgd,bnkhd->bnhgqk', qb, keys).astype(jnp.float32) * scale
    qpos = jnp.arange(BLOCK)[:, None]
    kpos = jnp.arange(2 * BLOCK)[None, :] - BLOCK
    rel = qpos - kpos
    band = (rel >= 0) & (rel < WINDOW)
    blk = jnp.arange(nb)[:, None, None]
    valid = band[None] & ((blk > 0) | (kpos[None] >= 0))
    scores = jnp.where(valid[None, :, None, None], scores, -jnp.inf)
    sink = sinks.astype(jnp.float32).reshape(N_KV_HEADS, GQA_GROUP)[None, None, :, :, None, None]
    sink = jnp.broadcast_to(sink, scores.shape[:-1] + (1,))
    probs = jax.nn.softmax(jnp.concatenate([scores, sink], axis=-1), axis=-1)[..., :-1]
    out = jnp.einsum('bnhgqk,bnkhd->bnqhgd', probs.astype(v.dtype), vals)
    return out.reshape(bsz, seq, N_Q_HEADS * dh)


def swiglu(h, w_in, w_out):
    gu = h @ w_in
    gate, up = jnp.split(gu, 2, axis=-1)
    return (jax.nn.silu(gate) * up) @ w_out


def setup_inputs(seed: int = 0) -> dict:
    key = jax.random.key(seed)
    ks = jax.random.split(key, 26)
    f32 = jnp.float32

    def nrm(k, shape, scale):
        return jax.random.normal(k, shape, f32) * scale

    def gain(k, shape):
        return 1.0 + 0.02 * jax.random.normal(k, shape, f32)

    G, P, H = N_SSM_GROUPS, SSM_STATE, SSM_GROUP_WIDTH
    n_idx = jnp.arange(P, dtype=f32)
    ssm_a_re = -0.5 + 0.01 * jax.random.normal(ks[3], (DEPTH, G, P), f32)
    ssm_a_im = math.pi * n_idx[None, None, :] + 0.01 * jax.random.normal(ks[4], (DEPTH, G, P), f32)
    ssm_log_dt = jax.random.uniform(ks[5], (DEPTH, G), f32,
                                    math.log(DT_MIN), math.log(DT_MAX))
    return {
        "x": nrm(ks[0], (BATCH, SEQ, D_MODEL), 1.0),
        "p": nrm(ks[1], (DEPTH, BATCH, SEQ, PLE_DIM), 1.0),
        "norm_mix": gain(ks[2], (DEPTH, D_MODEL)),
        "w_in": nrm(ks[6], (DEPTH, D_MODEL, IN_WIDTH), D_MODEL ** -0.5),
        "ssm_a_re": ssm_a_re,
        "ssm_a_im": ssm_a_im,
        "ssm_log_dt": ssm_log_dt,
        "ssm_b_re": nrm(ks[7], (DEPTH, G, P, H), (2 * H) ** -0.5),
        "ssm_b_im": nrm(ks[8], (DEPTH, G, P, H), (2 * H) ** -0.5),
        "ssm_c_re": nrm(ks[9], (DEPTH, G, H, P), (2 * P) ** -0.5),
        "ssm_c_im": nrm(ks[10], (DEPTH, G, H, P), (2 * P) ** -0.5),
        "ssm_d": nrm(ks[11], (DEPTH, SSM_WIDTH), 1.0),
        "ssm_w_glu": nrm(ks[12], (DEPTH, SSM_WIDTH, SSM_WIDTH), SSM_WIDTH ** -0.5),
        "attn_sinks": nrm(ks[13], (DEPTH, N_Q_HEADS), 0.5),
        "norm_ssm_out": gain(ks[14], (DEPTH, SSM_WIDTH)),
        "norm_attn_out": gain(ks[15], (DEPTH, ATTN_WIDTH)),
        "w_out": nrm(ks[16], (DEPTH, MIX_WIDTH, D_MODEL), MIX_WIDTH ** -0.5),
        "norm_ffn": gain(ks[17], (DEPTH, D_MODEL)),
        "w_ffn_in": nrm(ks[18], (DEPTH, D_MODEL, 2 * FFN_HIDDEN), D_MODEL ** -0.5),
        "w_ffn_out": nrm(ks[19], (DEPTH, FFN_HIDDEN, D_MODEL), FFN_HIDDEN ** -0.5),
        "norm_ple": gain(ks[20], (DEPTH, D_MODEL)),
        "w_ple_gate": nrm(ks[21], (DEPTH, D_MODEL, D_MODEL), D_MODEL ** -0.5),
        "w_ple_proj": nrm(ks[22], (DEPTH, PLE_DIM, D_MODEL), PLE_DIM ** -0.5),
        "norm_final": gain(ks[23], (D_MODEL,)),
    }


def reference(x, p, norm_mix, w_in, ssm_a_re, ssm_a_im, ssm_log_dt, ssm_b_re, ssm_b_im,
              ssm_c_re, ssm_c_im, ssm_d, ssm_w_glu, attn_sinks, norm_ssm_out, norm_attn_out,
              w_out, norm_ffn, w_ffn_in, w_ffn_out, norm_ple, w_ple_gate, w_ple_proj,
              norm_final):
    bsz, seq, _ = x.shape
    h = x
    splits = [SSM_WIDTH, SSM_WIDTH + ATTN_WIDTH, SSM_WIDTH + ATTN_WIDTH + KV_WIDTH]
    for i in range(DEPTH):
        hn = rms_norm(h, norm_mix[i])
        proj = hn @ w_in[i]
        u, q, k, v = jnp.split(proj, splits, axis=-1)
        ssm_out = s5_mixer(u, ssm_a_re[i], ssm_a_im[i], ssm_log_dt[i], ssm_b_re[i], ssm_b_im[i],
                           ssm_c_re[i], ssm_c_im[i], ssm_d[i], ssm_w_glu[i])
        attn_out = sliding_window_attention(
            q.reshape(bsz, seq, N_Q_HEADS, HEAD_DIM),
            k.reshape(bsz, seq, N_KV_HEADS, HEAD_DIM),
            v.reshape(bsz, seq, N_KV_HEADS, HEAD_DIM),
            attn_sinks[i])
        mixed = jnp.concatenate([rms_norm(ssm_out, norm_ssm_out[i]),
                                 rms_norm(attn_out, norm_attn_out[i])], axis=-1)
        h = h + mixed @ w_out[i]
        h = h + swiglu(rms_norm(h, norm_ffn[i]), w_ffn_in[i], w_ffn_out[i])
        gate = jax.nn.sigmoid(rms_norm(h, norm_ple[i]) @ w_ple_gate[i])
        h = h + gate * (p[i] @ w_ple_proj[i])
    return rms_norm(h, norm_final)
```

```cpp
#include <hip/hip_runtime.h>
#include <hip/hip_cooperative_groups.h>
#include <cstdio>
#include <cstdint>
namespace cg = cooperative_groups;

#ifndef MK_MULTI
#define MK_MULTI 0
#endif

#ifndef PROBE_REP
#define PROBE_REP 0
#endif
#ifndef PH_MASK
#define PH_MASK 0xFFFF
#endif
#define PH_EN(k) (((PH_MASK) >> (k)) & 1)
#define LAS __attribute__((address_space(3)))
#define GAS __attribute__((address_space(1)))
typedef unsigned short bf16_t;
typedef short bf16x8 __attribute__((ext_vector_type(8)));
typedef short bf16x4 __attribute__((ext_vector_type(4)));
typedef float f32x4 __attribute__((ext_vector_type(4)));
typedef float f32x2 __attribute__((ext_vector_type(2)));
typedef unsigned u32x4 __attribute__((ext_vector_type(4)));
typedef unsigned u32x2 __attribute__((ext_vector_type(2)));

constexpr int DM = 1024, BATCH = 8, SEQ = 4096, DEPTH = 4, MTOK = BATCH * SEQ;
constexpr int SSMW = 512, NG = 32, NS = 64, ATTW = 512, KVW = 128, INW = 1280, FFH = 2816, PLE = 256;
constexpr float EPS = 1e-6f;
constexpr float QSCALE = 0.125f * 1.4426950408889634f;
constexpr float LOG2E = 1.4426950408889634f;

constexpr size_t MiB = 1u << 20;
constexpr size_t WS_SSQ = 472 * MiB;
constexpr size_t WS_BMAT = 4 * MiB;
constexpr size_t WS_CMAT = 5 * MiB;
constexpr size_t WS_LAM = 6 * MiB;
constexpr size_t WS_W = 8 * MiB, W_LAYER = 24 * MiB;
constexpr size_t WO_IN = 0, WO_GLU = 2 * MiB + 512 * 1024, WO_OUT = 3 * MiB, WO_FI = 5 * MiB, WO_FO = 16 * MiB, WO_G = 21 * MiB + 512 * 1024, WO_P = 23 * MiB + 512 * 1024;
constexpr size_t WS_HB = 104 * MiB;
constexpr size_t WS_PB = 168 * MiB;
constexpr size_t WS_PP = 232 * MiB;
constexpr size_t WS_OV = 296 * MiB;
constexpr size_t WS_HID = WS_OV;
constexpr size_t WS_UG = WS_OV, WS_Q = WS_OV + 32 * MiB, WS_K = WS_OV + 64 * MiB, WS_V = WS_OV + 72 * MiB, WS_YG = WS_OV + 80 * MiB, WS_MIX = WS_OV + 112 * MiB;
constexpr size_t WS_END = 478 * MiB;
static_assert(WO_P + (size_t)1024 * 256 * 2 <= W_LAYER, "weight map");
static_assert(WS_HID + (size_t)MTOK * FFH * 2 <= WS_SSQ && WS_MIX + (size_t)MTOK * 1024 * 2 <= WS_SSQ, "ws map");

constexpr int LDS_BYTES = 147456;
constexpr int LDS_FAC_OFF = 131072, LDS_BAR_OFF = 147440;
constexpr size_t WS_CTL = 0, CTL_ZERO_BYTES = 16384;
constexpr int NPHASE = 1 + 7 * DEPTH + 1;

__device__ __forceinline__ unsigned cvt_pk_bf16(float lo, float hi) { unsigned r; asm volatile("v_cvt_pk_bf16_f32 %0, %1, %2" : "=v"(r) : "v"(lo), "v"(hi)); return r; }
__device__ __forceinline__ unsigned f2bf(float f) { unsigned u = __builtin_bit_cast(unsigned, f); return (u + 0x7fffu + ((u >> 16) & 1u)) >> 16; }
__device__ __forceinline__ float bflo(unsigned w) { return __builtin_bit_cast(float, w << 16); }
__device__ __forceinline__ float bfhi(unsigned w) { return __builtin_bit_cast(float, w & 0xffff0000u); }
__device__ __forceinline__ float sigm(float x) { return __builtin_amdgcn_rcpf(1.f + __builtin_amdgcn_exp2f(-LOG2E * x)); }
#define LDS_WAIT() asm volatile("s_waitcnt lgkmcnt(0)" ::: "memory")
#ifndef WT_STORES
#define WT_STORES 0
#endif
__device__ __forceinline__ void st16(void* p, u32x4 v) {
#if WT_STORES
    asm volatile("global_store_dwordx4 %0, %1, off sc0 sc1" :: "v"(p), "v"(v) : "memory");
#else
    *(u32x4*)p = v;
#endif
}
#define LBAR() do { asm volatile("s_waitcnt lgkmcnt(0)" ::: "memory"); __builtin_amdgcn_s_barrier(); asm volatile("" ::: "memory"); } while (0)
typedef unsigned long long ssq_t;
__device__ __forceinline__ void ssq_add(ssq_t* p, float v) { atomicAdd(p, (ssq_t)(v * 268435456.f)); }
__device__ __forceinline__ float ssq_get(const ssq_t* p) { return (float)(*p) * (1.f / 268435456.f); }
__device__ __forceinline__ int opaque_tid() { int t = threadIdx.x; asm volatile("" : "+v"(t)); return t; }

namespace pg8 {
constexpr int BM = 256, BK = 64, HALF = 128, HTB = HALF * BK * 2, STAGE_BYTES = 8 * HTB, NXCD = 8, WGM = 4;
__host__ __device__ __forceinline__ int lds_byte(int r, int c) { const int st = (r >> 4) * 2 + (c >> 5), rr = r & 15, cc = c & 31, ob = rr * 64 + cc * 2; return st * 1024 + (ob ^ (((ob >> 9) & 1) << 5)); }
__host__ __device__ __forceinline__ void stage_rc(int b, int& R, int& C) { const int st = b / 1024, sb = b % 1024, swz = sb ^ (((sb >> 9) & 1) << 5); R = (st >> 1) * 16 + swz / 64; C = (st & 1) * 32 + (swz % 64) / 2; }
__host__ __device__ __forceinline__ int perm32(int rho) { const int n = rho >> 4, i = rho & 15; return 8 * (i >> 2) + 4 * n + (i & 3); }

struct Unit { int pm, pn; };
struct Gemm { const bf16_t* A; const bf16_t* Bt; int M, N, K; };

struct StaticOrder {
    int nM, nN, nwg, G, c;
    __host__ __device__ void init(int M, int N, int G_, int c_) { nM = M / BM; nN = N / BM; nwg = nM * nN; G = G_; c = c_; }
    __host__ __device__ bool next(int i, Unit& u) const {
        const long L = (long)i * G + c; if (L >= nwg) return false;
        int wgid = (int)L; { const int q = nwg / NXCD, r = nwg % NXCD, xcd = wgid % NXCD, off = wgid / NXCD; wgid = (xcd < r ? xcd * (q + 1) : r * (q + 1) + (xcd - r) * q) + off; }
        const int nig = WGM * nN, gid = wgid / nig, fm = gid * WGM, gsz = (nM - fm) < WGM ? (nM - fm) : WGM;
        u.pm = fm + ((wgid % nig) % gsz); u.pn = (wgid % nig) / gsz; return true;
    }
};

template <class Epi>
__device__ __forceinline__ void gemm_phase(LAS unsigned char* lds, const Gemm g, const StaticOrder& S, const Epi& E) {
    const int tid = opaque_tid(), wid = __builtin_amdgcn_readfirstlane(tid >> 6), lane = tid & 63, wr = wid >> 2, wc = wid & 3, fr = lane & 15, fq = lane >> 4;
    const int K = g.K, nt = K / BK;
    unsigned voffA, voffB;
    { int R, C; stage_rc(tid * 16, R, C); const int Rb = Epi::PERM ? ((R & ~31) + perm32(R & 31)) : R;
        voffA = (unsigned)(R * K + C) * 2u; voffB = (unsigned)(Rb * K + C) * 2u; }
    const size_t pstep = (size_t)64 * K * 2;
    const size_t kstep = (size_t)(BK * 2);
    const size_t hstep = (size_t)HALF * K * 2;
    const size_t tstep = 2 * hstep;
    const unsigned ldsw = (unsigned)wid * 1024u;
    const int aoff = lds_byte(wr * 64 + fr, fq * 8), boff = lds_byte(wc * 32 + fr, fq * 8);
#define PG8_SA(b, h) (((b) * 2 + (h)) * HTB)
#define PG8_SB(b, h) ((4 + (b) * 2 + (h)) * HTB)
#define PG8_STAGE(bufoff, gbase, voff) do { _Pragma("unroll") for (int _i = 0; _i < 2; ++_i) \
        __builtin_amdgcn_global_load_lds((const unsigned*)((const char*)(gbase) + _i * pstep + (voff)), (LAS unsigned*)(lds + (bufoff) + ldsw + _i * 8192), 16, 0, 0); } while (0)
#define PG8_LDA(dst, b, h) do { _Pragma("unroll") for (int m = 0; m < 4; ++m) _Pragma("unroll") for (int k = 0; k < 2; ++k) dst[m][k] = *(const LAS bf16x8*)(lds + PG8_SA(b, h) + aoff + m * 2048 + k * 1024); } while (0)
#define PG8_LDB(dst, b, h) do { _Pragma("unroll") for (int n = 0; n < 2; ++n) _Pragma("unroll") for (int k = 0; k < 2; ++k) dst[n][k] = *(const LAS bf16x8*)(lds + PG8_SB(b, h) + boff + n * 2048 + k * 1024); } while (0)
#define PG8_MMA(ai, bj, At, Bt) do { __builtin_amdgcn_s_setprio(1); _Pragma("unroll") for (int m = 0; m < 4; ++m) _Pragma("unroll") for (int n = 0; n < 2; ++n) _Pragma("unroll") for (int k = 0; k < 2; ++k) \
        acc[ai][bj][m][n] = __builtin_amdgcn_mfma_f32_16x16x32_bf16(Bt[n][k], At[m][k], acc[ai][bj][m][n], 0, 0, 0); __builtin_amdgcn_s_setprio(0); } while (0)
#define PG8_WAIT_V(n) asm volatile("s_waitcnt vmcnt(" #n ")" ::: "memory")
#define PG8_WAIT_L(n) asm volatile("s_waitcnt lgkmcnt(" #n ")" ::: "memory")
#define PG8_BAR __builtin_amdgcn_s_barrier()
#define PG8_SCHED __builtin_amdgcn_sched_barrier(0)
    Unit cur, nxt; int ui = 0;
    if (!S.next(0, cur)) return;
    f32x4 acc[2][2][4][2];
#pragma unroll
    for (int a = 0; a < 2; ++a)
#pragma unroll
        for (int b = 0; b < 2; ++b)
#pragma unroll
            for (int m = 0; m < 4; ++m)
#pragma unroll
                for (int n = 0; n < 2; ++n) acc[a][b][m][n] = (f32x4){0.f, 0.f, 0.f, 0.f};
    bf16x8 At[4][2], B0[2][2], B1[2][2];
    const char* cA = (const char*)g.A + (size_t)cur.pm * tstep; const char* cB = (const char*)g.Bt + (size_t)cur.pn * tstep;
    PG8_STAGE(PG8_SB(0, 0), cB, voffB); PG8_STAGE(PG8_SB(0, 1), cB + hstep, voffB); PG8_STAGE(PG8_SA(0, 0), cA, voffA); PG8_STAGE(PG8_SA(0, 1), cA + hstep, voffA);
    if (wr == 1) PG8_BAR;
    PG8_WAIT_V(2); PG8_BAR;
    PG8_STAGE(PG8_SB(1, 0), cB + kstep, voffB); PG8_STAGE(PG8_SA(1, 0), cA + kstep, voffA); PG8_STAGE(PG8_SB(1, 1), cB + hstep + kstep, voffB);
    PG8_WAIT_V(6); PG8_BAR;
    for (;;) {
        const bool has_next = S.next(ui + 1, nxt);
        const char* nA = has_next ? (const char*)g.A + (size_t)nxt.pm * tstep : cA; const char* nB = has_next ? (const char*)g.Bt + (size_t)nxt.pn * tstep : cB;
#pragma unroll 1
        for (int t = 0; t < nt; t += 2) {
            const bool last = (t == nt - 2);
            const char* a1 = cA + (size_t)(t + 1) * kstep;
            const char* a2 = last ? nA : cA + (size_t)(t + 2) * kstep; const char* b2 = last ? nB : cB + (size_t)(t + 2) * kstep;
            const char* a3 = a2 + kstep; const char* b3 = b2 + kstep;
            if constexpr (Epi::MID) { if (t == (nt >> 1)) E.mid(acc, ui, wr, wc, fr, fq); }
            PG8_LDB(B0, 0, 0); PG8_LDB(B1, 0, 1); PG8_SCHED; PG8_LDA(At, 0, 0); PG8_STAGE(PG8_SA(1, 1), a1 + hstep, voffA);
            PG8_WAIT_V(8); PG8_WAIT_L(0); PG8_BAR; PG8_MMA(0, 0, At, B0); PG8_MMA(0, 1, At, B1); PG8_BAR; PG8_SCHED;
            PG8_LDA(At, 0, 1); PG8_STAGE(PG8_SB(0, 0), b2, voffB); PG8_STAGE(PG8_SB(0, 1), b2 + hstep, voffB); PG8_STAGE(PG8_SA(0, 0), a2, voffA);
            PG8_WAIT_V(8); PG8_WAIT_L(0); PG8_BAR; PG8_MMA(1, 0, At, B0); PG8_MMA(1, 1, At, B1); PG8_BAR; PG8_SCHED;
            PG8_LDB(B0, 1, 0); PG8_LDB(B1, 1, 1); PG8_SCHED; PG8_LDA(At, 1, 0); PG8_STAGE(PG8_SA(0, 1), a2 + hstep, voffA);
            PG8_WAIT_V(8); PG8_WAIT_L(0); PG8_BAR; PG8_MMA(0, 0, At, B0); PG8_MMA(0, 1, At, B1); PG8_BAR; PG8_SCHED;
            PG8_LDA(At, 1, 1); PG8_STAGE(PG8_SB(1, 0), b3, voffB); PG8_STAGE(PG8_SB(1, 1), b3 + hstep, voffB); PG8_STAGE(PG8_SA(1, 0), a3, voffA);
            PG8_WAIT_V(8); PG8_WAIT_L(0); PG8_BAR; PG8_MMA(1, 0, At, B0); PG8_MMA(1, 1, At, B1); PG8_BAR; PG8_SCHED;
        }
        if (wr == 0) PG8_BAR;
        E(acc, cur, ui, wr, wc, fr, fq);
        if (!has_next) break;
#pragma unroll
        for (int a = 0; a < 2; ++a)
#pragma unroll
            for (int b = 0; b < 2; ++b)
#pragma unroll
                for (int m = 0; m < 4; ++m)
#pragma unroll
                    for (int n = 0; n < 2; ++n) acc[a][b][m][n] = (f32x4){0.f, 0.f, 0.f, 0.f};
        cur = nxt; cA = nA; cB = nB; ++ui;
        if (wr == 1) PG8_BAR;
    }
    PG8_WAIT_V(0);
    PG8_BAR;
#undef PG8_SA
#undef PG8_SB
#undef PG8_STAGE
#undef PG8_LDA
#undef PG8_LDB
#undef PG8_MMA
#undef PG8_WAIT_V
#undef PG8_WAIT_L
#undef PG8_BAR
#undef PG8_SCHED
}

typedef f32x4 Acc[2][2][4][2];

struct EpiInProj {
    static constexpr bool PERM = true, MID = false;
    const ssq_t* ssq; bf16_t *UG, *Q, *K, *V;
    __device__ __forceinline__ void operator()(const Acc& acc, const Unit& u, int ui, int wr, int wc, int fr, int fq) const {
        const int row0 = u.pm * BM + wr * 64 + fr;
#pragma unroll
        for (int ai = 0; ai < 2; ++ai)
#pragma unroll
            for (int m = 0; m < 4; ++m) {
                const int row = row0 + ai * HALF + m * 16;
                const float rs = rsqrtf(ssq_get(ssq + row) * (1.f / 1024.f) + EPS);
#pragma unroll
                for (int bj = 0; bj < 2; ++bj) {
                    const int c = u.pn * BM + bj * HALF + wc * 32 + 8 * fq;
                    float sc = rs; bf16_t* dst;
                    if (c < 512) dst = UG + ((size_t)(c >> 4) * MTOK + row) * 16 + (c & 15);
                    else if (c < 1024) { dst = Q + (size_t)row * 512 + (c - 512); sc *= QSCALE; }
                    else if (c < 1152) dst = K + (size_t)row * 128 + (c - 1024);
                    else dst = V + (size_t)row * 128 + (c - 1152);
                    const f32x4 v0 = acc[ai][bj][m][0] * sc, v1 = acc[ai][bj][m][1] * sc;
                    u32x4 w; w.x = cvt_pk_bf16(v0[0], v0[1]); w.y = cvt_pk_bf16(v0[2], v0[3]); w.z = cvt_pk_bf16(v1[0], v1[1]); w.w = cvt_pk_bf16(v1[2], v1[3]);
                    st16(dst, w);
                }
            }
    }
};

struct EpiGlu {
    static constexpr bool PERM = true, MID = false;
    const bf16_t* YG; bf16_t* MIX; ssq_t* ssq;
    __device__ __forceinline__ void operator()(const Acc& acc, const Unit& u, int ui, int wr, int wc, int fr, int fq) const {
        const int row0 = u.pm * BM + wr * 64 + fr;
#pragma unroll
        for (int ai = 0; ai < 2; ++ai)
#pragma unroll
            for (int m = 0; m < 4; ++m) {
                const int row = row0 + ai * HALF + m * 16; float part = 0.f;
#pragma unroll
                for (int bj = 0; bj < 2; ++bj) {
                    const int c = u.pn * BM + bj * HALF + wc * 32 + 8 * fq;
                    const u32x4 yw = *(const u32x4*)(YG + (size_t)row * 512 + c);
                    const f32x4 z0 = acc[ai][bj][m][0], z1 = acc[ai][bj][m][1];
                    float o[8];
                    o[0] = bflo(yw.x) * sigm(z0[0]); o[1] = bfhi(yw.x) * sigm(z0[1]); o[2] = bflo(yw.y) * sigm(z0[2]); o[3] = bfhi(yw.y) * sigm(z0[3]);
                    o[4] = bflo(yw.z) * sigm(z1[0]); o[5] = bfhi(yw.z) * sigm(z1[1]); o[6] = bflo(yw.w) * sigm(z1[2]); o[7] = bfhi(yw.w) * sigm(z1[3]);
#pragma unroll
                    for (int j = 0; j < 8; ++j) part += o[j] * o[j];
                    u32x4 w; w.x = cvt_pk_bf16(o[0], o[1]); w.y = cvt_pk_bf16(o[2], o[3]); w.z = cvt_pk_bf16(o[4], o[5]); w.w = cvt_pk_bf16(o[6], o[7]);
                    st16(MIX + (size_t)row * 1024 + c, w);
                }
                part += __shfl_xor(part, 16); part += __shfl_xor(part, 32);
                if (fq == 0) ssq_add(ssq + row, part);
            }
    }
};

struct EpiPlain {
    static constexpr bool PERM = true, MID = false;
    bf16_t* O;
    __device__ __forceinline__ void operator()(const Acc& acc, const Unit& u, int ui, int wr, int wc, int fr, int fq) const {
        const int row0 = u.pm * BM + wr * 64 + fr;
#pragma unroll
        for (int ai = 0; ai < 2; ++ai)
#pragma unroll
            for (int m = 0; m < 4; ++m) {
                const int row = row0 + ai * HALF + m * 16;
#pragma unroll
                for (int bj = 0; bj < 2; ++bj) {
                    const int c = u.pn * BM + bj * HALF + wc * 32 + 8 * fq;
                    const f32x4 v0 = acc[ai][bj][m][0], v1 = acc[ai][bj][m][1];
                    u32x4 w; w.x = cvt_pk_bf16(v0[0], v0[1]); w.y = cvt_pk_bf16(v0[2], v0[3]); w.z = cvt_pk_bf16(v1[0], v1[1]); w.w = cvt_pk_bf16(v1[2], v1[3]);
                    st16(O + (size_t)row * 1024 + c, w);
                }
            }
    }
};

struct EpiFfnIn {
    static constexpr bool PERM = true, MID = false;
    const ssq_t* ssq; bf16_t* HID;
    __device__ __forceinline__ void operator()(const Acc& acc, const Unit& u, int ui, int wr, int wc, int fr, int fq) const {
        const int row0 = u.pm * BM + wr * 64 + fr; const int c = u.pn * HALF + wc * 32 + 8 * fq;
#pragma unroll
        for (int ai = 0; ai < 2; ++ai)
#pragma unroll
            for (int m = 0; m < 4; ++m) {
                const int row = row0 + ai * HALF + m * 16;
                const float rs = rsqrtf(ssq_get(ssq + row) * (1.f / 1024.f) + EPS);
                const float c1 = -LOG2E * rs, c2 = rs * rs;
                float o[8];
#pragma unroll
                for (int n = 0; n < 2; ++n)
#pragma unroll
                    for (int j = 0; j < 4; j += 2) { const f32x2 g2 = {acc[ai][0][m][n][j], acc[ai][0][m][n][j + 1]}, u2 = {acc[ai][1][m][n][j], acc[ai][1][m][n][j + 1]};
                        const f32x2 ea = g2 * c1; f32x2 dn; dn.x = __builtin_amdgcn_exp2f(ea.x); dn.y = __builtin_amdgcn_exp2f(ea.y); dn = dn + 1.0f;
                        f32x2 rc; rc.x = __builtin_amdgcn_rcpf(dn.x); rc.y = __builtin_amdgcn_rcpf(dn.y);
                        const f32x2 r2 = (g2 * u2) * (rc * c2); o[n * 4 + j] = r2.x; o[n * 4 + j + 1] = r2.y; }
                u32x4 w; w.x = cvt_pk_bf16(o[0], o[1]); w.y = cvt_pk_bf16(o[2], o[3]); w.z = cvt_pk_bf16(o[4], o[5]); w.w = cvt_pk_bf16(o[6], o[7]);
                st16(HID + (size_t)row * FFH + c, w);
            }
    }
};

template <int MODE> struct EpiRes {
    static constexpr bool PERM = true, MID = (MODE == 1);
    const bf16_t* HR; bf16_t* HW; ssq_t* ssq_out; const ssq_t* ssq_a; const bf16_t* PP; const LAS f32x2* fac;
    __device__ __forceinline__ void mid(Acc& acc, int ui, int wr, int wc, int fr, int fq) const {
        const LAS f32x2* T = fac + (ui & 3) * 256 + wr * 64 + fr;
#pragma unroll
        for (int ai = 0; ai < 2; ++ai)
#pragma unroll
            for (int m = 0; m < 4; ++m) {
                const float f = T[ai * HALF + m * 16].x;
#pragma unroll
                for (int bj = 0; bj < 2; ++bj)
#pragma unroll
                    for (int n = 0; n < 2; ++n) acc[ai][bj][m][n] = acc[ai][bj][m][n] * f;
            }
    }
    __device__ __forceinline__ void operator()(const Acc& acc, const Unit& u, int ui, int wr, int wc, int fr, int fq) const {
        const int row0 = u.pm * BM + wr * 64 + fr; const int col0 = u.pn * BM + wc * 32 + 8 * fq;
        constexpr int MB = (MODE == 2) ? 2 : 4;
#pragma unroll
        for (int ai = 0; ai < 2; ++ai)
#pragma unroll
        for (int mb = 0; mb < 4; mb += MB) {
            u32x4 hw[4][2], pw[4][2]; float rs[4];
#pragma unroll
            for (int m = mb; m < mb + MB; ++m) {
                const int row = row0 + ai * HALF + m * 16; const size_t off = (size_t)row * 1024 + col0;
#pragma unroll
                for (int bj = 0; bj < 2; ++bj) { hw[m][bj] = *(const u32x4*)(HR + off + bj * HALF); if (MODE == 2) pw[m][bj] = *(const u32x4*)(PP + off + bj * HALF); }
                rs[m] = 1.f;
                if (MODE == 1) rs[m] = fac[(ui & 3) * 256 + wr * 64 + fr + ai * HALF + m * 16].y;
                if (MODE == 2) rs[m] = ssq_get(ssq_a + row);
            }
#pragma unroll
            for (int m = mb; m < mb + MB; ++m) {
                const int row = row0 + ai * HALF + m * 16; const size_t off = (size_t)row * 1024 + col0; float part = 0.f;
                const float r = (MODE == 2) ? rsqrtf(rs[m] * (1.f / 1024.f) + EPS) : rs[m];
#pragma unroll
                for (int bj = 0; bj < 2; ++bj) {
                    const size_t o2 = off + bj * HALF;
                    const u32x4 h4 = hw[m][bj];
                    const f32x4 a0 = acc[ai][bj][m][0], a1 = acc[ai][bj][m][1];
                    float d[8] = {a0[0], a0[1], a0[2], a0[3], a1[0], a1[1], a1[2], a1[3]};
                    if (MODE == 1) {
#pragma unroll
                        for (int j = 0; j < 8; ++j) d[j] *= r;
                    }
                    if (MODE == 2) { const u32x4 p4 = pw[m][bj];
                        const float pp[8] = {bflo(p4.x), bfhi(p4.x), bflo(p4.y), bfhi(p4.y), bflo(p4.z), bfhi(p4.z), bflo(p4.w), bfhi(p4.w)};
#pragma unroll
                        for (int j = 0; j < 8; ++j) d[j] = sigm(d[j] * r) * pp[j]; }
                    float o[8];
                    o[0] = bflo(h4.x) + d[0]; o[1] = bfhi(h4.x) + d[1]; o[2] = bflo(h4.y) + d[2]; o[3] = bfhi(h4.y) + d[3];
                    o[4] = bflo(h4.z) + d[4]; o[5] = bfhi(h4.z) + d[5]; o[6] = bflo(h4.w) + d[6]; o[7] = bfhi(h4.w) + d[7];
                    u32x4 w; w.x = cvt_pk_bf16(o[0], o[1]); w.y = cvt_pk_bf16(o[2], o[3]); w.z = cvt_pk_bf16(o[4], o[5]); w.w = cvt_pk_bf16(o[6], o[7]);
                    st16(HW + o2, w);
#pragma unroll
                    for (int j = 0; j < 8; ++j) part += o[j] * o[j];
                }
                part += __shfl_xor(part, 16); part += __shfl_xor(part, 32);
                if (fq == 0) ssq_add(ssq_out + row, part);
            }
            asm volatile("" ::: "memory");
        }
    }
};
}

struct Args { const float* in[24]; float* out; unsigned char* ws; int ph_lo, ph_hi; };
enum { I_X = 0, I_P, I_NMIX, I_WIN, I_ARE, I_AIM, I_LDT, I_BRE, I_BIM, I_CRE, I_CIM, I_D, I_WGLU, I_SINK, I_NSSM, I_NATT, I_WOUT, I_NFFN, I_WFI, I_WFO, I_NPLE, I_WG, I_WP, I_NFIN };

__device__ __forceinline__ ssq_t* ssq_ptr(unsigned char* ws, int l, int type) { return (ssq_t*)(ws + WS_SSQ) + ((size_t)l * 6 + type) * MTOK; }

__device__ __forceinline__ void tr_item(const float* W, int K, int N, bf16_t* WT, const float* s0, const float* s1, int ksplit, bool ffn_map, LAS float* scr, int item, int lane) {
    const int nblk = N / 32, kb = item / nblk, nb = item % nblk, k0 = 64 * kb, n0 = 32 * nb;
    float wv[32];
#pragma unroll
    for (int i = 0; i < 32; ++i) { const int kk = 2 * i + (lane >> 5); wv[i] = W[(size_t)(k0 + kk) * N + n0 + (lane & 31)]; }
    if (s0) {
#pragma unroll
        for (int i = 0; i < 32; ++i) { const int k = k0 + 2 * i + (lane >> 5); const float* sp = (k < ksplit) ? (s0 + k) : (s1 + (k - ksplit)); wv[i] *= *sp; } }
#pragma unroll
    for (int i = 0; i < 32; ++i) { const int kk = 2 * i + (lane >> 5); scr[kk * 33 + (lane & 31)] = wv[i]; }
    LDS_WAIT();
    int nr0 = n0;
    if (ffn_map) { if (n0 < FFH) nr0 = 256 * (n0 / 128) + (n0 % 128); else { const int j = n0 - FFH; nr0 = 256 * (j / 128) + 128 + (j % 128); } }
    const int c = lane & 7;
#pragma unroll
    for (int j = 0; j < 4; ++j) { const int n = (lane >> 3) + 8 * j; const LAS float* s = scr + (8 * c) * 33 + n;
        u32x4 o; o.x = cvt_pk_bf16(s[0 * 33], s[1 * 33]); o.y = cvt_pk_bf16(s[2 * 33], s[3 * 33]); o.z = cvt_pk_bf16(s[4 * 33], s[5 * 33]); o.w = cvt_pk_bf16(s[6 * 33], s[7 * 33]);
        *(u32x4*)(WT + (size_t)(nr0 + n) * K + k0 + 8 * c) = o; }
    LDS_WAIT();
}

__device__ __forceinline__ float wave_sum(float v) {
#pragma unroll
    for (int o = 1; o < 64; o <<= 1) v += __shfl_xor(v, o);
    return v;
}

__device__ __forceinline__ void sincos_acc(float x, float& s, float& c) {
    const float nf = rintf(x * 0.6366197723675814f); const int n = (int)nf;
    float r = __builtin_fmaf(nf, -1.5707962513e+00f, x); r = __builtin_fmaf(nf, -7.5497894159e-08f, r); r = __builtin_fmaf(nf, -5.3903029534e-15f, r);
    const float r2 = r * r;
    float sp = __builtin_fmaf(r2, 2.7557319224e-06f, -1.9841269841e-04f); sp = __builtin_fmaf(sp, r2, 8.3333333333e-03f); sp = __builtin_fmaf(sp, r2, -1.6666666667e-01f); sp = __builtin_fmaf(sp * r2, r, r);
    float cp = __builtin_fmaf(r2, -2.7557319224e-07f, 2.4801587302e-05f); cp = __builtin_fmaf(cp, r2, -1.3888888889e-03f); cp = __builtin_fmaf(cp, r2, 4.1666666667e-02f); cp = __builtin_fmaf(cp, r2, -0.5f); cp = __builtin_fmaf(cp, r2, 1.0f);
    const int q = n & 3;
    const float ss = (q & 1) ? cp : sp, cc = (q & 1) ? sp : cp;
    s = (q & 2) ? -ss : ss; c = ((q + 1) & 2) ? -cc : cc;
}

__device__ __forceinline__ void prologue(const Args& a, LAS unsigned char* lds, unsigned char* ws) {
    const int tid = opaque_tid(), lane = tid & 63, wave = tid >> 6;
    const int G = gridDim.x, gw = blockIdx.x * 8 + wave, NGW = G * 8;
    const int gtid = blockIdx.x * 512 + tid, NT = G * 512;
    LAS float* scr = (LAS float*)(lds + wave * 16384);
    constexpr int IT_IN = 16 * 40, IT_GLU = 8 * 16, IT_OUT = 16 * 32, IT_FI = 16 * 176, IT_FO = 44 * 32, IT_G = 16 * 32, IT_P = 4 * 32;
    constexpr int IT_L = IT_IN + IT_GLU + IT_OUT + IT_FI + IT_FO + IT_G + IT_P;
    for (int it = gw; it < IT_L * DEPTH; it += NGW) {
        const int l = it / IT_L; int r = it % IT_L;
        unsigned char* wl = ws + WS_W + (size_t)l * W_LAYER;
        if (r < IT_IN) { tr_item(a.in[I_WIN] + (size_t)l * DM * INW, DM, INW, (bf16_t*)(wl + WO_IN), a.in[I_NMIX] + l * DM, a.in[I_NMIX] + l * DM, DM, false, scr, r, lane); continue; } r -= IT_IN;
        if (r < IT_GLU) { tr_item(a.in[I_WGLU] + (size_t)l * SSMW * SSMW, SSMW, SSMW, (bf16_t*)(wl + WO_GLU), nullptr, nullptr, 0, false, scr, r, lane); continue; } r -= IT_GLU;
        if (r < IT_OUT) { tr_item(a.in[I_WOUT] + (size_t)l * DM * DM, DM, DM, (bf16_t*)(wl + WO_OUT), a.in[I_NSSM] + l * SSMW, a.in[I_NATT] + l * ATTW, SSMW, false, scr, r, lane); continue; } r -= IT_OUT;
        if (r < IT_FI) { tr_item(a.in[I_WFI] + (size_t)l * DM * 2 * FFH, DM, 2 * FFH, (bf16_t*)(wl + WO_FI), a.in[I_NFFN] + l * DM, a.in[I_NFFN] + l * DM, DM, true, scr, r, lane); continue; } r -= IT_FI;
        if (r < IT_FO) { tr_item(a.in[I_WFO] + (size_t)l * FFH * DM, FFH, DM, (bf16_t*)(wl + WO_FO), nullptr, nullptr, 0, false, scr, r, lane); continue; } r -= IT_FO;
        if (r < IT_G) { tr_item(a.in[I_WG] + (size_t)l * DM * DM, DM, DM, (bf16_t*)(wl + WO_G), a.in[I_NPLE] + l * DM, a.in[I_NPLE] + l * DM, DM, false, scr, r, lane); continue; } r -= IT_G;
        tr_item(a.in[I_WP] + (size_t)l * PLE * DM, PLE, DM, (bf16_t*)(wl + WO_P), nullptr, nullptr, 0, false, scr, r, lane);
    }
    {
        ssq_t* ssq0 = ssq_ptr(ws, 0, 0); bf16_t* HB = (bf16_t*)(ws + WS_HB);
        for (int m = gw; m < MTOK; m += 2 * NGW) {
            const int m2 = m + NGW;
            const bool has2 = m2 < MTOK; const int mm2 = has2 ? m2 : m;
            const f32x4* xr = (const f32x4*)(a.in[I_X] + (size_t)m * DM) + lane; const f32x4* xr2 = (const f32x4*)(a.in[I_X] + (size_t)mm2 * DM) + lane;
            f32x4 v[4], v2[4];
#pragma unroll
            for (int j = 0; j < 4; ++j) { v[j] = xr[64 * j]; v2[j] = xr2[64 * j]; }
            u32x2* hb = (u32x2*)(HB + (size_t)m * DM) + lane; u32x2* hb2 = (u32x2*)(HB + (size_t)mm2 * DM) + lane;
            float s = 0.f, s2 = 0.f;
#pragma unroll
            for (int j = 0; j < 4; ++j) { u32x2 w; w.x = cvt_pk_bf16(v[j][0], v[j][1]); w.y = cvt_pk_bf16(v[j][2], v[j][3]); hb[64 * j] = w; s += (v[j][0] * v[j][0] + v[j][1] * v[j][1]) + (v[j][2] * v[j][2] + v[j][3] * v[j][3]);
                u32x2 w2; w2.x = cvt_pk_bf16(v2[j][0], v2[j][1]); w2.y = cvt_pk_bf16(v2[j][2], v2[j][3]); if (has2) hb2[64 * j] = w2; s2 += (v2[j][0] * v2[j][0] + v2[j][1] * v2[j][1]) + (v2[j][2] * v2[j][2] + v2[j][3] * v2[j][3]); }
            s = wave_sum(s); s2 = wave_sum(s2);
            if (lane == 0) { ssq0[m] = (ssq_t)(s * 268435456.f); if (has2) ssq0[m2] = (ssq_t)(s2 * 268435456.f); }
        }
    }
    {
        const f32x4* p4 = (const f32x4*)a.in[I_P]; u32x4* pb = (u32x4*)(ws + WS_PB);
        const int n8 = DEPTH * MTOK * PLE / 8;
#pragma unroll 4
        for (int i = gtid; i < n8; i += NT) { const f32x4 v0 = p4[2 * i], v1 = p4[2 * i + 1]; u32x4 w; w.x = cvt_pk_bf16(v0[0], v0[1]); w.y = cvt_pk_bf16(v0[2], v0[3]); w.z = cvt_pk_bf16(v1[0], v1[1]); w.w = cvt_pk_bf16(v1[2], v1[3]); pb[i] = w; }
    }
    {
        u32x4* z = (u32x4*)(ws + WS_SSQ); const int n4 = DEPTH * 6 * MTOK / 2;
        for (int i = gtid; i < n4; i += NT) if (i >= MTOK / 2) z[i] = (u32x4){0u, 0u, 0u, 0u};
    }
    if (gtid < DEPTH * NG * NS) {
        const int l = gtid >> 11, g = (gtid >> 6) & 31, p = gtid & 63, lg = l * NG + g;
        const float dt = __expf(a.in[I_LDT][lg]);
        const float ar = a.in[I_ARE][lg * NS + p], ai = a.in[I_AIM][lg * NS + p];
        const float mag = __expf(ar * dt); float sn, cs; sincos_acc(ai * dt, sn, cs);
        const float lr = mag * cs, li = mag * sn;
        const float den = ar * ar + ai * ai, nr = lr - 1.f, ni = li;
        const float fr = (nr * ar + ni * ai) / den, fi = (ni * ar - nr * ai) / den;
        bf16_t* Bm = (bf16_t*)(ws + WS_BMAT) + (size_t)lg * 128 * 16; bf16_t* Cm = (bf16_t*)(ws + WS_CMAT) + (size_t)lg * 16 * 128;
        const float* bre = a.in[I_BRE] + ((size_t)lg * NS + p) * 16; const float* bim = a.in[I_BIM] + ((size_t)lg * NS + p) * 16;
#pragma unroll
        for (int h = 0; h < 16; ++h) { const float br = bre[h], bi = bim[h];
            Bm[p * 16 + h] = (bf16_t)f2bf(fr * br - fi * bi); Bm[(64 + p) * 16 + h] = (bf16_t)f2bf(fr * bi + fi * br);
            Cm[h * 128 + 2 * p] = (bf16_t)f2bf(a.in[I_CRE][((size_t)lg * 16 + h) * NS + p]); Cm[h * 128 + 2 * p + 1] = (bf16_t)f2bf(-a.in[I_CIM][((size_t)lg * 16 + h) * NS + p]); }
        f32x2* lam = (f32x2*)(ws + WS_LAM); lam[lg * NS + p] = (f32x2){lr, li};
    }
}

constexpr int SSM_BU = 0, SSM_BU_STRIDE = 260;
constexpr int SSM_X = 0, SSM_X_STRIDE = 272;
constexpr int SSM_E = 128 * 260 * 4;
constexpr int SSM_U = SSM_E + 8 * 64 * 8;
static_assert(SSM_U + 256 * 32 <= LDS_BAR_OFF && 256 * SSM_X_STRIDE <= SSM_E, "S5 LDS map");
__device__ __forceinline__ void ssm_item(LAS unsigned char* lds, int b, int g, int l, const Args& a, unsigned char* ws) {
    const int tid = opaque_tid(), lane = tid & 63, w = __builtin_amdgcn_readfirstlane(tid >> 6), fr = lane & 15, fq = lane >> 4;
    const int lg = l * NG + g;
    const bf16_t* UGg = (const bf16_t*)(ws + WS_UG) + ((size_t)g * MTOK + (size_t)b * SEQ) * 16;
    const bf16_t* Bm = (const bf16_t*)(ws + WS_BMAT) + (size_t)lg * 128 * 16; const bf16_t* Cm = (const bf16_t*)(ws + WS_CMAT) + (size_t)lg * 16 * 128;
    bf16_t* YG = (bf16_t*)(ws + WS_YG) + (size_t)b * SEQ * 512 + g * 16;
    LAS float* BuS = (LAS float*)(lds + SSM_BU); LAS f32x2* Es = (LAS f32x2*)(lds + SSM_E); LAS unsigned char* XS = lds + SSM_X; LAS unsigned char* US = lds + SSM_U;
    const int p = lane, t0 = 32 * w;
    const bf16x8 zero8 = {0, 0, 0, 0, 0, 0, 0, 0};
    bf16x8 bB[8];
#pragma unroll
    for (int j = 0; j < 8; ++j) { const bf16x8 t = *(const bf16x8*)(Bm + (j * 16 + fr) * 16 + 8 * (fq & 1)); bB[j] = (fq < 2) ? t : zero8; asm volatile("" : "+v"(bB[j])); }
    bf16x8 cB[4];
#pragma unroll
    for (int ks = 0; ks < 4; ++ks) { cB[ks] = *(const bf16x8*)(Cm + fr * 128 + ks * 32 + 8 * fq); asm volatile("" : "+v"(cB[ks])); }
    const float dsk = a.in[I_D][l * SSMW + g * 16 + fr];
    const f32x2 lam = ((const f32x2*)(ws + WS_LAM))[lg * NS + p];
    const float lr = lam.x, li = lam.y;
    const f32x2 lrr = {lr, lr}, lii = {-li, li};
    float l32r = lr, l32i = li;
#pragma unroll
    for (int j = 0; j < 5; ++j) { const float nr = l32r * l32r - l32i * l32i, ni = 2.f * l32r * l32i; l32r = nr; l32i = ni; }
    float xpr = 0.f, xpi = 0.f;
    bf16x8 a_next[2];
#pragma unroll
    for (int i = 0; i < 2; ++i) { const bf16x8 t = *(const bf16x8*)(UGg + (size_t)(t0 + 16 * i + fr) * 16 + 8 * (fq & 1)); a_next[i] = (fq < 2) ? t : zero8; }
#pragma unroll 1
    for (int c = 0; c < SEQ / 256; ++c) {
        bf16x8 a_cur[2] = {a_next[0], a_next[1]};
        { const int cn = (c + 1 < SEQ / 256) ? c + 1 : c;
#pragma unroll
            for (int i = 0; i < 2; ++i) { const bf16x8 t = *(const bf16x8*)(UGg + (size_t)(cn * 256 + t0 + 16 * i + fr) * 16 + 8 * (fq & 1)); a_next[i] = (fq < 2) ? t : zero8; }
        }
#pragma unroll
        for (int i = 0; i < 2; ++i) {
            if (fq < 2) *(LAS bf16x8*)(US + (t0 + 16 * i + fr) * 32 + fq * 16) = a_cur[i];
#pragma unroll
            for (int j = 0; j < 8; ++j) {
                const f32x4 d = __builtin_amdgcn_mfma_f32_16x16x32_bf16(a_cur[i], bB[j], (f32x4){0.f, 0.f, 0.f, 0.f}, 0, 0, 0);
                *(LAS f32x4*)(BuS + (j * 16 + fr) * SSM_BU_STRIDE + t0 + 16 * i + 4 * fq) = d;
            }
        }
        LBAR();
        f32x2 xl[32]; { f32x2 x = {0.f, 0.f};
#pragma unroll
            for (int j4 = 0; j4 < 8; ++j4) { const f32x4 br4 = *(const LAS f32x4*)(BuS + p * SSM_BU_STRIDE + t0 + 4 * j4), bi4 = *(const LAS f32x4*)(BuS + (64 + p) * SSM_BU_STRIDE + t0 + 4 * j4);
#pragma unroll
                for (int r = 0; r < 4; ++r) { const int j = 4 * j4 + r; const f32x2 bb = {br4[r], bi4[r]}; const f32x2 xs = {x.y, x.x};
                    x = lrr * x + (lii * xs + bb); xl[j] = x; } }
            Es[w * 64 + p] = x; }
        LBAR();
        { float cr = xpr, ci = xpi, mr = 0.f, mi = 0.f;
#pragma unroll
            for (int j = 0; j < 8; ++j) { if (j == w) { mr = cr; mi = ci; } const f32x2 e = Es[j * 64 + p];
                const float nr = l32r * cr - l32i * ci + e.x, ni = l32r * ci + l32i * cr + e.y; cr = nr; ci = ni; }
            xpr = cr; xpi = ci;
            f32x2 mm = {mr, mi};
#pragma unroll
            for (int j = 0; j < 32; ++j) { const f32x2 ms = {mm.y, mm.x}; mm = lrr * mm + lii * ms;
                const f32x2 X = xl[j] + mm;
                *(LAS unsigned*)(XS + (t0 + j) * SSM_X_STRIDE + p * 4) = cvt_pk_bf16(X.x, X.y); } }
        LBAR();
#pragma unroll
        for (int i = 0; i < 2; ++i) {
            f32x4 y = (f32x4){0.f, 0.f, 0.f, 0.f};
#pragma unroll
            for (int ks = 0; ks < 4; ++ks) { const bf16x8 xa = *(const LAS bf16x8*)(XS + (t0 + 16 * i + fr) * SSM_X_STRIDE + ks * 64 + fq * 16);
                y = __builtin_amdgcn_mfma_f32_16x16x32_bf16(xa, cB[ks], y, 0, 0, 0); }
#pragma unroll
            for (int r = 0; r < 4; ++r) { const int tl = t0 + 16 * i + 4 * fq + r;
                const float uu = bflo((unsigned)*(const LAS bf16_t*)(US + tl * 32 + fr * 2));
                const float v = y[r] + dsk * uu;
                const float o = v * sigm(1.5957691216f * (v + 0.044715f * v * v * v));
                YG[(size_t)(c * 256 + tl) * 512 + fr] = (bf16_t)(cvt_pk_bf16(o, 0.f) & 0xffffu); }
        }
        LBAR();
    }
    __syncthreads();
}

constexpr int ATT_KS = 0, ATT_K_STRIDE = 272;
constexpr int ATT_VT = 256 * 272, ATT_V_STRIDE = 528;
static_assert(ATT_VT + 128 * ATT_V_STRIDE <= LDS_BYTES, "attention LDS");
__device__ __forceinline__ void attn_item(LAS unsigned char* lds, int b, int nb, int l, const Args& a, unsigned char* ws, int ssq_type = 2) {
    const int tid = opaque_tid(), lane = tid & 63, w = __builtin_amdgcn_readfirstlane(tid >> 6), fr = lane & 15, fq = lane >> 4;
    const bf16_t* Qg = (const bf16_t*)(ws + WS_Q); const bf16_t* Kg = (const bf16_t*)(ws + WS_K); const bf16_t* Vg = (const bf16_t*)(ws + WS_V);
    bf16_t* MIX = (bf16_t*)(ws + WS_MIX); ssq_t* ssq_att = ssq_ptr(ws, l, ssq_type);
    const int row0 = b * SEQ + nb * 128;
    const int krow0 = row0 - 128;
#pragma unroll
    for (int i = 0; i < 8; ++i) { const int pi = tid + i * 512, r = pi >> 4, cp = pi & 15;
        const bool ok = (nb > 0 || r >= 128);
        u32x4 v = *(const u32x4*)(Kg + (size_t)(ok ? krow0 + r : row0) * 128 + cp * 8);
        if (!ok) v = (u32x4){0u, 0u, 0u, 0u};
        *(LAS u32x4*)(lds + ATT_KS + r * ATT_K_STRIDE + cp * 16) = v; }
#pragma unroll
    for (int i = 0; i < 8; ++i) { const int pi = tid + i * 512, r = pi & 255, cp = pi >> 8;
        const bool ok = (nb > 0 || r >= 128);
        u32x4 v = *(const u32x4*)(Vg + (size_t)(ok ? krow0 + r : row0) * 128 + cp * 8);
        if (!ok) v = (u32x4){0u, 0u, 0u, 0u};
        LAS unsigned char* vb = lds + ATT_VT + (cp * 8) * ATT_V_STRIDE + r * 2;
        *(LAS bf16_t*)(vb + 0 * ATT_V_STRIDE) = (bf16_t)(v.x & 0xffffu); *(LAS bf16_t*)(vb + 1 * ATT_V_STRIDE) = (bf16_t)(v.x >> 16);
        *(LAS bf16_t*)(vb + 2 * ATT_V_STRIDE) = (bf16_t)(v.y & 0xffffu); *(LAS bf16_t*)(vb + 3 * ATT_V_STRIDE) = (bf16_t)(v.y >> 16);
        *(LAS bf16_t*)(vb + 4 * ATT_V_STRIDE) = (bf16_t)(v.z & 0xffffu); *(LAS bf16_t*)(vb + 5 * ATT_V_STRIDE) = (bf16_t)(v.z >> 16);
        *(LAS bf16_t*)(vb + 6 * ATT_V_STRIDE) = (bf16_t)(v.w & 0xffffu); *(LAS bf16_t*)(vb + 7 * ATT_V_STRIDE) = (bf16_t)(v.w >> 16); }
    __syncthreads();
    const int h = w, kvh = w >> 2;
    const float sink2 = a.in[I_SINK][l * 8 + h] * LOG2E;
    const float NEG = -__builtin_inff();
    bf16x8 qn0 = *(const bf16x8*)(Qg + (size_t)(row0 + fr) * 512 + h * 64 + 8 * fq), qn1 = *(const bf16x8*)(Qg + (size_t)(row0 + fr) * 512 + h * 64 + 32 + 8 * fq);
    for (int qt = 0; qt < 8; ++qt) {
        const bf16x8 q0 = qn0, q1 = qn1;
        if (qt < 7) { qn0 = *(const bf16x8*)(Qg + (size_t)(row0 + (qt + 1) * 16 + fr) * 512 + h * 64 + 8 * fq); qn1 = *(const bf16x8*)(Qg + (size_t)(row0 + (qt + 1) * 16 + fr) * 512 + h * 64 + 32 + 8 * fq); }
        f32x4 s[9];
#pragma unroll
        for (int i = 0; i < 9; ++i) {
            const LAS unsigned char* kp = lds + ATT_KS + (16 * (qt + i) + fr) * ATT_K_STRIDE + kvh * 128 + fq * 16;
            const bf16x8 k0 = *(const LAS bf16x8*)kp, k1 = *(const LAS bf16x8*)(kp + 64);
            f32x4 d = __builtin_amdgcn_mfma_f32_16x16x32_bf16(k0, q0, (f32x4){0.f, 0.f, 0.f, 0.f}, 0, 0, 0);
            s[i] = __builtin_amdgcn_mfma_f32_16x16x32_bf16(k1, q1, d, 0, 0, 0);
        }
#pragma unroll
        for (int r = 0; r < 4; ++r) { if (!(4 * fq + r > fr)) s[0][r] = NEG; if (!(4 * fq + r <= fr)) s[8][r] = NEG; }
        if (nb == 0) {
#pragma unroll
            for (int i = 0; i < 8; ++i) if (i < 8 - qt) s[i] = (f32x4){NEG, NEG, NEG, NEG};
        }
        float mx = sink2;
#pragma unroll
        for (int i = 0; i < 9; ++i) mx = fmaxf(mx, fmaxf(fmaxf(s[i][0], s[i][1]), fmaxf(s[i][2], s[i][3])));
        mx = fmaxf(mx, __shfl_xor(mx, 16)); mx = fmaxf(mx, __shfl_xor(mx, 32));
        float sum = 0.f;
#pragma unroll
        for (int i = 0; i < 9; ++i)
#pragma unroll
            for (int r = 0; r < 4; ++r) { const float e = __builtin_amdgcn_exp2f(s[i][r] - mx); s[i][r] = e; sum += e; }
        sum += __shfl_xor(sum, 16); sum += __shfl_xor(sum, 32);
        sum += __builtin_amdgcn_exp2f(sink2 - mx);
        const float inv = __builtin_amdgcn_rcpf(sum);
        f32x4 o[4];
#pragma unroll
        for (int dt = 0; dt < 4; ++dt) o[dt] = (f32x4){0.f, 0.f, 0.f, 0.f};
#pragma unroll
        for (int i = 0; i < 8; i += 2) {
            u32x4 pw; pw.x = cvt_pk_bf16(s[i][0], s[i][1]); pw.y = cvt_pk_bf16(s[i][2], s[i][3]); pw.z = cvt_pk_bf16(s[i + 1][0], s[i + 1][1]); pw.w = cvt_pk_bf16(s[i + 1][2], s[i + 1][3]);
            const bf16x8 pb = __builtin_bit_cast(bf16x8, pw);
#pragma unroll
            for (int dt = 0; dt < 4; ++dt) {
                const LAS unsigned char* vp = lds + ATT_VT + (kvh * 64 + dt * 16 + fr) * ATT_V_STRIDE + (16 * (qt + i) + 4 * fq) * 2;
                const u32x2 va = *(const LAS u32x2*)vp, vb = *(const LAS u32x2*)(vp + 32);
                u32x4 vw; vw.x = va.x; vw.y = va.y; vw.z = vb.x; vw.w = vb.y;
                o[dt] = __builtin_amdgcn_mfma_f32_16x16x32_bf16(__builtin_bit_cast(bf16x8, vw), pb, o[dt], 0, 0, 0);
            }
        }
        {
            u32x2 pw; pw.x = cvt_pk_bf16(s[8][0], s[8][1]); pw.y = cvt_pk_bf16(s[8][2], s[8][3]);
            const bf16x4 pb = __builtin_bit_cast(bf16x4, pw);
#pragma unroll
            for (int dt = 0; dt < 4; ++dt) {
                const LAS unsigned char* vp = lds + ATT_VT + (kvh * 64 + dt * 16 + fr) * ATT_V_STRIDE + (16 * (qt + 8) + 4 * fq) * 2;
                const u32x2 va = *(const LAS u32x2*)vp;
                o[dt] = __builtin_amdgcn_mfma_f32_16x16x16bf16_1k(__builtin_bit_cast(bf16x4, va), pb, o[dt], 0, 0, 0);
            }
        }
        const int row = row0 + qt * 16 + fr; float part = 0.f;
#pragma unroll
        for (int dt = 0; dt < 4; ++dt) { const f32x4 v = o[dt] * inv; part += (v[0] * v[0] + v[1] * v[1]) + (v[2] * v[2] + v[3] * v[3]);
            u32x2 wv; wv.x = cvt_pk_bf16(v[0], v[1]); wv.y = cvt_pk_bf16(v[2], v[3]);
            *(u32x2*)(MIX + (size_t)row * 1024 + 512 + h * 64 + dt * 16 + 4 * fq) = wv; }
        part += __shfl_xor(part, 16); part += __shfl_xor(part, 32);
        if (fq == 0) ssq_add(ssq_att + row, part);
    }
    __syncthreads();
}

#define XB_TMO      128
#define XB_XCNT(j)  (256  + 64 * (j))
#define XB_XSUB(j)  (1280 + 64 * (j))
#define XB_XGEN(j)  (2304 + 64 * (j))
#define XB_TOP      3328
#define XB_TOPGEN   3392
#define XCD_BAR_WORDS 3456
#define XB_SPIN_CAP (1u << 20)
__device__ __forceinline__ unsigned xb_ld(unsigned* p)              { return __hip_atomic_load(p, __ATOMIC_RELAXED, __HIP_MEMORY_SCOPE_AGENT); }
__device__ __forceinline__ unsigned xb_add(unsigned* p, unsigned v) { return __hip_atomic_fetch_add(p, v, __ATOMIC_RELAXED, __HIP_MEMORY_SCOPE_AGENT); }
__device__ __forceinline__ unsigned xb_xcc_id() { return (unsigned)__builtin_amdgcn_s_getreg((3 << 11) | 20) & 0xFu; }
#define XB_SPIN(cond, bar) do { unsigned _sp = 0; while (cond) { __builtin_amdgcn_s_sleep(1); \
    if ((++_sp & 255u) == 0u) { if (xb_ld(&(bar)[XB_TMO])) break; if (_sp > XB_SPIN_CAP) { atomicAdd(&(bar)[XB_TMO], 1u); break; } } } } while (0)
struct XcdBarrier { unsigned* bar; unsigned x; volatile LAS unsigned* st; };
__device__ __forceinline__ XcdBarrier xcd_barrier_post(unsigned* bar, volatile LAS unsigned* st) {
    XcdBarrier b; b.bar = bar; b.x = xb_xcc_id(); b.st = st;
    if (threadIdx.x == 0) (void)xb_add(&bar[XB_XCNT(b.x)], 1u);
    return b;
}
__device__ __forceinline__ void xcd_barrier_complete(unsigned* bar, unsigned x, unsigned& nloc, unsigned& nx) {
    const unsigned G = gridDim.x * gridDim.y * gridDim.z;
    unsigned sum, cnt, mine, sp = 0u;
    for (;;) {
        sum = 0u; cnt = 0u; mine = 0u;
#pragma unroll
        for (unsigned j = 0; j < 16; ++j) { const unsigned c = xb_ld(&bar[XB_XCNT(j)]); sum += c; cnt += (c > 0u) ? 1u : 0u; mine = (j == x) ? c : mine; }
        if (sum == G) break;
        __builtin_amdgcn_s_sleep(1);
        if ((++sp & 255u) == 0u) { if (xb_ld(&bar[XB_TMO])) break; if (sp > XB_SPIN_CAP) { atomicAdd(&bar[XB_TMO], 1u); break; } }
    }
    nloc = mine > 0u ? mine : 1u; nx = cnt > 0u ? cnt : 1u;
}
__device__ __forceinline__ void xcd_barrier(const XcdBarrier& b) {
    asm volatile("s_waitcnt vmcnt(0)" ::: "memory");
    __syncthreads();
    if (threadIdx.x == 0) {
        unsigned* bar = b.bar;
        __builtin_amdgcn_s_waitcnt(0);
        unsigned nloc = b.st[0], nx = b.st[1];
        if (nloc == 0u) { xcd_barrier_complete(bar, b.x, nloc, nx); b.st[0] = nloc; b.st[1] = nx; }
        const unsigned old = xb_add(&bar[XB_XSUB(b.x)], 1u);
        const unsigned gen = old / nloc;
        if (old + 1u == (gen + 1u) * nloc) {
            __builtin_amdgcn_fence(__ATOMIC_RELEASE, "agent");
            asm volatile("s_waitcnt vmcnt(0)" ::: "memory");
            const unsigned og = xb_add(&bar[XB_TOP], 1u);
            const unsigned tg = og / nx;
            if (og + 1u == (tg + 1u) * nx) xb_add(&bar[XB_TOPGEN], 1u);
            else XB_SPIN(xb_ld(&bar[XB_TOPGEN]) == tg, bar);
            __builtin_amdgcn_fence(__ATOMIC_ACQUIRE, "agent");
            xb_add(&bar[XB_XGEN(b.x)], 1u);
            asm volatile("s_waitcnt vmcnt(0)" ::: "memory");
        } else {
            XB_SPIN(xb_ld(&bar[XB_XGEN(b.x)]) == gen, bar);
            __builtin_amdgcn_fence(__ATOMIC_ACQUIRE, "agent");
            asm volatile("s_waitcnt vmcnt(0)" ::: "memory");
        }
    }
    __syncthreads();
}

__global__ void __launch_bounds__(512, 2) hymba_fwd(Args a_in) {
    extern __shared__ __attribute__((aligned(16))) unsigned char lds_raw[];
    LAS unsigned char* lds = (LAS unsigned char*)lds_raw;
    const int G = gridDim.x, bx = blockIdx.x;
    int ph = a_in.ph_lo; const int ph_hi = a_in.ph_hi;
    volatile LAS unsigned* bst = (volatile LAS unsigned*)(lds + LDS_BAR_OFF);
    if (threadIdx.x < 2) bst[threadIdx.x] = 0u;
    __syncthreads();
#if MK_MULTI
    const XcdBarrier xbar = xcd_barrier_post((unsigned*)(a_in.ws + WS_CTL), bst);
#endif
    if (ph == 0) {
#if !MK_MULTI
        if (bx == 0) { unsigned* bw = (unsigned*)(a_in.ws + WS_CTL); for (int i = threadIdx.x; i < XCD_BAR_WORDS; i += 512) bw[i] = 0u; }
#endif
        if (PH_EN(9)) for (int rep = 0; rep < 1 + ((PROBE_REP >> 2) & 1); ++rep) { prologue(a_in, lds, a_in.ws); __syncthreads(); }
        __syncthreads(); ++ph;
        if (ph < ph_hi) cg::this_grid().sync();
    }
#if !MK_MULTI
    const XcdBarrier xbar = xcd_barrier_post((unsigned*)(a_in.ws + WS_CTL), bst);
#endif
    for (; ph < ph_hi && ph < NPHASE - 1; ++ph) {
        const Args& a = a_in;
        size_t zoff = 0; asm volatile("" : "+s"(zoff));
        unsigned char* ws = a.ws + zoff;
        bf16_t* HB1 = (bf16_t*)a.out + zoff; bf16_t* HB0 = (bf16_t*)(ws + WS_HB);
        const int l = (ph - 1) / 7, j = (ph - 1) % 7;
        unsigned char* wl = ws + WS_W + (size_t)l * W_LAYER;
        pg8::StaticOrder S;
        if (j == 0) { if (PH_EN(0)) {
            pg8::Gemm g{HB0, (const bf16_t*)(wl + WO_IN), MTOK, INW, DM}; S.init(MTOK, INW, G, bx);
            pg8::EpiInProj E{ssq_ptr(ws, l, 0), (bf16_t*)(ws + WS_UG), (bf16_t*)(ws + WS_Q), (bf16_t*)(ws + WS_K), (bf16_t*)(ws + WS_V)};
            pg8::gemm_phase(lds, g, S, E);
            if (PH_EN(4) && G == 256) { pg8::Gemm g2{(const bf16_t*)(ws + WS_PB) + (size_t)l * MTOK * PLE, (const bf16_t*)(wl + WO_P), MTOK, DM, PLE};
              pg8::StaticOrder S2; S2.init(MTOK, DM, 128, bx >= 128 ? bx - 128 : (1 << 20));
              pg8::EpiPlain E2{(bf16_t*)(ws + WS_PP)};
              pg8::gemm_phase(lds, g2, S2, E2); } }
        } else if (j == 1) {
            if (PH_EN(1)) for (int rep = 0; rep < 1 + (PROBE_REP & 1); ++rep) for (int it = bx; it < BATCH * NG; it += G) ssm_item(lds, it >> 5, it & 31, l, a, ws);
            if (PH_EN(2)) for (int rep = 0; rep < 1 + ((PROBE_REP >> 1) & 1); ++rep) for (int it = bx; it < BATCH * (SEQ / 128); it += G) attn_item(lds, it >> 5, it & 31, l, a, ws, rep ? 5 : 2);
        } else if (j == 2) {
            if (PH_EN(3)) { pg8::Gemm g{(const bf16_t*)(ws + WS_YG), (const bf16_t*)(wl + WO_GLU), MTOK, SSMW, SSMW}; S.init(MTOK, SSMW, G, bx);
              pg8::EpiGlu E{(const bf16_t*)(ws + WS_YG), (bf16_t*)(ws + WS_MIX), ssq_ptr(ws, l, 1)};
              pg8::gemm_phase(lds, g, S, E); }
            if (PH_EN(4) && G != 256) { pg8::Gemm g{(const bf16_t*)(ws + WS_PB) + (size_t)l * MTOK * PLE, (const bf16_t*)(wl + WO_P), MTOK, DM, PLE}; S.init(MTOK, DM, G, bx);
              pg8::EpiPlain E{(bf16_t*)(ws + WS_PP)};
              pg8::gemm_phase(lds, g, S, E); }
        } else if (j == 3) { if (PH_EN(5)) {
            pg8::Gemm g{(const bf16_t*)(ws + WS_MIX), (const bf16_t*)(wl + WO_OUT), MTOK, DM, DM}; S.init(MTOK, DM, G, bx);
            LAS f32x2* fac = (LAS f32x2*)(lds + LDS_FAC_OFF);
            { const int t2 = opaque_tid(); const ssq_t* sa = ssq_ptr(ws, l, 1); const ssq_t* sb = ssq_ptr(ws, l, 2); pg8::Unit uu;
              for (int i = 0; i < 4 && S.next(i, uu); ++i) if (t2 < 256) { const int row = uu.pm * 256 + t2;
                  const float rs_s = rsqrtf(ssq_get(sa + row) * (1.f / 512.f) + EPS), rs_a = rsqrtf(ssq_get(sb + row) * (1.f / 512.f) + EPS); fac[i * 256 + t2] = (f32x2){rs_s / rs_a, rs_a}; }
              __syncthreads(); }
            pg8::EpiRes<1> E{HB0, HB1, ssq_ptr(ws, l, 3), nullptr, nullptr, fac};
            pg8::gemm_phase(lds, g, S, E); }
        } else if (j == 4) { if (PH_EN(6)) {
            pg8::Gemm g{HB1, (const bf16_t*)(wl + WO_FI), MTOK, 2 * FFH, DM}; S.init(MTOK, 2 * FFH, G, bx);
            pg8::EpiFfnIn E{ssq_ptr(ws, l, 3), (bf16_t*)(ws + WS_HID)};
            for (int rep = 0; rep < 1 + ((PROBE_REP >> 4) & 1); ++rep) pg8::gemm_phase(lds, g, S, E); }
        } else if (j == 5) { if (PH_EN(7)) {
            pg8::Gemm g{(const bf16_t*)(ws + WS_HID), (const bf16_t*)(wl + WO_FO), MTOK, DM, FFH}; S.init(MTOK, DM, G, bx);
            pg8::EpiRes<0> E{HB1, HB1, ssq_ptr(ws, l, 4), nullptr, nullptr, nullptr};
            pg8::gemm_phase(lds, g, S, E); }
        } else { if (PH_EN(8)) {
            pg8::Gemm g{HB1, (const bf16_t*)(wl + WO_G), MTOK, DM, DM}; S.init(MTOK, DM, G, bx);
            ssq_t* nxt = (l + 1 < DEPTH) ? ssq_ptr(ws, l + 1, 0) : ssq_ptr(ws, 0, 1);
            pg8::EpiRes<2> E{HB1, HB0, nxt, ssq_ptr(ws, l, 4), (const bf16_t*)(ws + WS_PP), nullptr};
            pg8::gemm_phase(lds, g, S, E); }
        }
        if (ph + 1 < ph_hi) { xcd_barrier(xbar); if (PROBE_REP & 8) xcd_barrier(xbar); }
    }
    if (ph == NPHASE - 1 && ph < ph_hi) { if (PH_EN(10)) {
        float* O = a_in.out; const bf16_t* HB0 = (const bf16_t*)(a_in.ws + WS_HB);
        const int tid = opaque_tid(), lane = tid & 63, gw = bx * 8 + (tid >> 6), NGW = G * 8;
        const f32x4* gf = (const f32x4*)a_in.in[I_NFIN] + 2 * lane;
        for (int m = gw; m < MTOK; m += 2 * NGW) {
            const int m2 = (m + NGW < MTOK) ? m + NGW : m;
            const u32x4* hr = (const u32x4*)(HB0 + (size_t)m * DM) + lane; const u32x4* hr2 = (const u32x4*)(HB0 + (size_t)m2 * DM) + lane;
            u32x4 wv[2][2];
#pragma unroll
            for (int j = 0; j < 2; ++j) { wv[0][j] = hr[64 * j]; wv[1][j] = hr2[64 * j]; }
#pragma unroll
            for (int q = 0; q < 2; ++q) { const int mr = q ? m2 : m; f32x4* orow = (f32x4*)(O + (size_t)mr * DM) + 2 * lane; float v[2][8]; float s = 0.f;
#pragma unroll
                for (int j = 0; j < 2; ++j) { const u32x4 w = wv[q][j]; v[j][0] = bflo(w.x); v[j][1] = bfhi(w.x); v[j][2] = bflo(w.y); v[j][3] = bfhi(w.y); v[j][4] = bflo(w.z); v[j][5] = bfhi(w.z); v[j][6] = bflo(w.w); v[j][7] = bfhi(w.w);
#pragma unroll
                    for (int k = 0; k < 8; ++k) s += v[j][k] * v[j][k]; }
                const float rs = rsqrtf(wave_sum(s) * (1.f / DM) + EPS);
                if (q == 0 || m2 != m) {
#pragma unroll
                for (int j = 0; j < 2; ++j) { const f32x4 g0 = gf[128 * j], g1 = gf[128 * j + 1];
                    orow[128 * j] = (f32x4){v[j][0] * rs * g0[0], v[j][1] * rs * g0[1], v[j][2] * rs * g0[2], v[j][3] * rs * g0[3]};
                    orow[128 * j + 1] = (f32x4){v[j][4] * rs * g1[0], v[j][5] * rs * g1[1], v[j][6] * rs * g1[2], v[j][7] * rs * g1[3]}; } } } } }
    }
}

extern "C" void kernel_launch(void* const* d_in, const int* in_sizes, int n_in, void* d_out, int out_size, void* d_ws, size_t ws_size, hipStream_t stream) {
    static int grid = 0;
    if (grid == 0) {
        if (n_in != 24 || out_size != MTOK * DM || ws_size < WS_END) { fprintf(stderr, "kernel_launch: unexpected problem: n_in %d out %d ws %zu\n", n_in, out_size, ws_size); grid = -1; return; }
        int dev = 0, cus = 0, per_cu = 0;
        (void)hipGetDevice(&dev); (void)hipDeviceGetAttribute(&cus, hipDeviceAttributeMultiprocessorCount, dev);
        if (hipFuncSetAttribute((const void*)hymba_fwd, hipFuncAttributeMaxDynamicSharedMemorySize, LDS_BYTES) != hipSuccess) { fprintf(stderr, "kernel_launch: hipFuncSetAttribute failed\n"); grid = -1; return; }
        if (hipOccupancyMaxActiveBlocksPerMultiprocessor(&per_cu, (const void*)hymba_fwd, 512, LDS_BYTES) != hipSuccess || per_cu < 1) { fprintf(stderr, "kernel_launch: occupancy query says %d\n", per_cu); per_cu = 1; }
        (void)hipGetLastError();
        grid = cus * 1;
        if (grid < 128) { fprintf(stderr, "kernel_launch: needs >= 128 CUs (phase D's factor table holds 4 units per workgroup), got %d\n", grid); grid = -1; return; }
        fprintf(stderr, "kernel_launch: cus %d per_cu %d grid %d\n", cus, per_cu, grid);
    }
    if (grid < 0) return;
#if MK_MULTI
    if (hipMemsetAsync((char*)d_ws + WS_CTL, 0, CTL_ZERO_BYTES, stream) != hipSuccess) { fprintf(stderr, "kernel_launch: memset of the barrier words failed\n"); return; }
#endif
    Args a{};
    for (int i = 0; i < 24; ++i) a.in[i] = (const float*)d_in[i];
    a.out = (float*)d_out; a.ws = (unsigned char*)d_ws;
#if MK_MULTI
    for (int ph = 0; ph < NPHASE; ++ph) { a.ph_lo = ph; a.ph_hi = ph + 1; hipLaunchKernelGGL(hymba_fwd, dim3(grid), dim3(512), LDS_BYTES, stream, a); }
#else
    a.ph_lo = 0; a.ph_hi = NPHASE;
    void* args[] = {&a};
    hipError_t e = hipLaunchCooperativeKernel((const void*)hymba_fwd, dim3(grid), dim3(512), args, LDS_BYTES, stream);
    if (e != hipSuccess) fprintf(stderr, "kernel_launch: cooperative launch failed: %s (grid %d)\n", hipGetErrorString(e), grid);
#endif
}
```

```cpp
#include <hip/hip_runtime.h>
#include <hip/hip_cooperative_groups.h>
#include <cstdio>
#include <cstdint>
namespace cg = cooperative_groups;

#ifndef MK_MULTI
#define MK_MULTI 0
#endif

#ifndef PROBE_REP
#define PROBE_REP 0
#endif
#ifndef PH_MASK
#define PH_MASK 0xFFFF
#endif
#define PH_EN(k) (((PH_MASK) >> (k)) & 1)
#define LAS __attribute__((address_space(3)))
#define GAS __attribute__((address_space(1)))
typedef unsigned short bf16_t;
typedef short bf16x8 __attribute__((ext_vector_type(8)));
typedef short bf16x4 __attribute__((ext_vector_type(4)));
typedef float f32x4 __attribute__((ext_vector_type(4)));
typedef float f32x2 __attribute__((ext_vector_type(2)));
typedef unsigned u32x4 __attribute__((ext_vector_type(4)));
typedef unsigned u32x2 __attribute__((ext_vector_type(2)));

constexpr int DM = 1024, BATCH = 8, SEQ = 4096, DEPTH = 4, MTOK = BATCH * SEQ;
constexpr int SSMW = 512, NG = 32, NS = 64, ATTW = 512, KVW = 128, INW = 1280, FFH = 2816, PLE = 256;
constexpr float EPS = 1e-6f;
constexpr float QSCALE = 0.125f * 1.4426950408889634f;
constexpr float LOG2E = 1.4426950408889634f;

constexpr size_t MiB = 1u << 20;
constexpr size_t WS_SSQ = 472 * MiB;
constexpr size_t WS_BMAT = 4 * MiB;
constexpr size_t WS_CMAT = 5 * MiB;
constexpr size_t WS_LAM = 6 * MiB;
constexpr size_t WS_W = 8 * MiB, W_LAYER = 24 * MiB;
constexpr size_t WO_IN = 0, WO_GLU = 2 * MiB + 512 * 1024, WO_OUT = 3 * MiB, WO_FI = 5 * MiB, WO_FO = 16 * MiB, WO_G = 21 * MiB + 512 * 1024, WO_P = 23 * MiB + 512 * 1024;
constexpr size_t WS_HB = 104 * MiB;
constexpr size_t WS_PB = 168 * MiB;
constexpr size_t WS_PP = 232 * MiB;
constexpr size_t WS_OV = 296 * MiB;
constexpr size_t WS_HID = WS_OV;
constexpr size_t WS_UG = WS_OV, WS_Q = WS_OV + 32 * MiB, WS_K = WS_OV + 64 * MiB, WS_V = WS_OV + 72 * MiB, WS_YG = WS_OV + 80 * MiB, WS_MIX = WS_OV + 112 * MiB;
constexpr size_t WS_END = 478 * MiB;
static_assert(WO_P + (size_t)1024 * 256 * 2 <= W_LAYER, "weight map");
static_assert(WS_HID + (size_t)MTOK * FFH * 2 <= WS_SSQ && WS_MIX + (size_t)MTOK * 1024 * 2 <= WS_SSQ, "ws map");

constexpr int LDS_BYTES = 147456;
constexpr int LDS_FAC_OFF = 131072, LDS_BAR_OFF = 147440;
constexpr size_t WS_CTL = 0, CTL_ZERO_BYTES = 16384;
constexpr int NPHASE = 1 + 7 * DEPTH + 1;

__device__ __forceinline__ unsigned cvt_pk_bf16(float lo, float hi) { unsigned r; asm volatile("v_cvt_pk_bf16_f32 %0, %1, %2" : "=v"(r) : "v"(lo), "v"(hi)); return r; }
__device__ __forceinline__ unsigned f2bf(float f) { unsigned u = __builtin_bit_cast(unsigned, f); return (u + 0x7fffu + ((u >> 16) & 1u)) >> 16; }
__device__ __forceinline__ float bflo(unsigned w) { return __builtin_bit_cast(float, w << 16); }
__device__ __forceinline__ float bfhi(unsigned w) { return __builtin_bit_cast(float, w & 0xffff0000u); }
__device__ __forceinline__ float sigm(float x) { return __builtin_amdgcn_rcpf(1.f + __builtin_amdgcn_exp2f(-LOG2E * x)); }
#define LDS_WAIT() asm volatile("s_waitcnt lgkmcnt(0)" ::: "memory")
#ifndef WT_STORES
#define WT_STORES 0
#endif
__device__ __forceinline__ void st16(void* p, u32x4 v) {
#if WT_STORES
    asm volatile("global_store_dwordx4 %0, %1, off sc0 sc1" :: "v"(p), "v"(v) : "memory");
#else
    *(u32x4*)p = v;
#endif
}
#define LBAR() do { asm volatile("s_waitcnt lgkmcnt(0)" ::: "memory"); __builtin_amdgcn_s_barrier(); asm volatile("" ::: "memory"); } while (0)
typedef unsigned long long ssq_t;
__device__ __forceinline__ void ssq_add(ssq_t* p, float v) { atomicAdd(p, (ssq_t)(v * 268435456.f)); }
__device__ __forceinline__ float ssq_get(const ssq_t* p) { return (float)(*p) * (1.f / 268435456.f); }
__device__ __forceinline__ int opaque_tid() { int t = threadIdx.x; asm volatile("" : "+v"(t)); return t; }

namespace pg8 {
constexpr int BM = 256, BK = 64, HALF = 128, HTB = HALF * BK * 2, STAGE_BYTES = 8 * HTB, NXCD = 8, WGM = 4;
__host__ __device__ __forceinline__ int lds_byte(int r, int c) { const int st = (r >> 4) * 2 + (c >> 5), rr = r & 15, cc = c & 31, ob = rr * 64 + cc * 2; return st * 1024 + (ob ^ (((ob >> 9) & 1) << 5)); }
__host__ __device__ __forceinline__ void stage_rc(int b, int& R, int& C) { const int st = b / 1024, sb = b % 1024, swz = sb ^ (((sb >> 9) & 1) << 5); R = (st >> 1) * 16 + swz / 64; C = (st & 1) * 32 + (swz % 64) / 2; }
__host__ __device__ __forceinline__ int perm32(int rho) { const int n = rho >> 4, i = rho & 15; return 8 * (i >> 2) + 4 * n + (i & 3); }

struct Unit { int pm, pn; };
struct Gemm { const bf16_t* A; const bf16_t* Bt; int M, N, K; };

struct StaticOrder {
    int nM, nN, nwg, G, c;
    __host__ __device__ void init(int M, int N, int G_, int c_) { nM = M / BM; nN = N / BM; nwg = nM * nN; G = G_; c = c_; }
    __host__ __device__ bool next(int i, Unit& u) const {
        const long L = (long)i * G + c; if (L >= nwg) return false;
        int wgid = (int)L; { const int q = nwg / NXCD, r = nwg % NXCD, xcd = wgid % NXCD, off = wgid / NXCD; wgid = (xcd < r ? xcd * (q + 1) : r * (q + 1) + (xcd - r) * q) + off; }
        const int nig = WGM * nN, gid = wgid / nig, fm = gid * WGM, gsz = (nM - fm) < WGM ? (nM - fm) : WGM;
        u.pm = fm + ((wgid % nig) % gsz); u.pn = (wgid % nig) / gsz; return true;
    }
};

template <class Epi>
__device__ __forceinline__ void gemm_phase(LAS unsigned char* lds, const Gemm g, const StaticOrder& S, const Epi& E) {
    const int tid = opaque_tid(), wid = __builtin_amdgcn_readfirstlane(tid >> 6), lane = tid & 63, wr = wid >> 2, wc = wid & 3, fr = lane & 15, fq = lane >> 4;
    const int K = g.K, nt = K / BK;
    unsigned voffA, voffB;
    { int R, C; stage_rc(tid * 16, R, C); const int Rb = Epi::PERM ? ((R & ~31) + perm32(R & 31)) : R;
        voffA = (unsigned)(R * K + C) * 2u; voffB = (unsigned)(Rb * K + C) * 2u; }
    const size_t pstep = (size_t)64 * K * 2;
    const size_t kstep = (size_t)(BK * 2);
    const size_t hstep = (size_t)HALF * K * 2;
    const size_t tstep = 2 * hstep;
    const unsigned ldsw = (unsigned)wid * 1024u;
    const int aoff = lds_byte(wr * 64 + fr, fq * 8), boff = lds_byte(wc * 32 + fr, fq * 8);
#define PG8_SA(b, h) (((b) * 2 + (h)) * HTB)
#define PG8_SB(b, h) ((4 + (b) * 2 + (h)) * HTB)
#define PG8_STAGE(bufoff, gbase, voff) do { _Pragma("unroll") for (int _i = 0; _i < 2; ++_i) \
        __builtin_amdgcn_global_load_lds((const unsigned*)((const char*)(gbase) + _i * pstep + (voff)), (LAS unsigned*)(lds + (bufoff) + ldsw + _i * 8192), 16, 0, 0); } while (0)
#define PG8_LDA(dst, b, h) do { _Pragma("unroll") for (int m = 0; m < 4; ++m) _Pragma("unroll") for (int k = 0; k < 2; ++k) dst[m][k] = *(const LAS bf16x8*)(lds + PG8_SA(b, h) + aoff + m * 2048 + k * 1024); } while (0)
#define PG8_LDB(dst, b, h) do { _Pragma("unroll") for (int n = 0; n < 2; ++n) _Pragma("unroll") for (int k = 0; k < 2; ++k) dst[n][k] = *(const LAS bf16x8*)(lds + PG8_SB(b, h) + boff + n * 2048 + k * 1024); } while (0)
#define PG8_MMA(ai, bj, At, Bt) do { __builtin_amdgcn_s_setprio(1); _Pragma("unroll") for (int m = 0; m < 4; ++m) _Pragma("unroll") for (int n = 0; n < 2; ++n) _Pragma("unroll") for (int k = 0; k < 2; ++k) \
        acc[ai][bj][m][n] = __builtin_amdgcn_mfma_f32_16x16x32_bf16(Bt[n][k], At[m][k], acc[ai][bj][m][n], 0, 0, 0); __builtin_amdgcn_s_setprio(0); } while (0)
#define PG8_WAIT_V(n) asm volatile("s_waitcnt vmcnt(" #n ")" ::: "memory")
#define PG8_WAIT_L(n) asm volatile("s_waitcnt lgkmcnt(" #n ")" ::: "memory")
#define PG8_BAR __builtin_amdgcn_s_barrier()
#define PG8_SCHED __builtin_amdgcn_sched_barrier(0)
    Unit cur, nxt; int ui = 0;
    if (!S.next(0, cur)) return;
    f32x4 acc[2][2][4][2];
#pragma unroll
    for (int a = 0; a < 2; ++a)
#pragma unroll
        for (int b = 0; b < 2; ++b)
#pragma unroll
            for (int m = 0; m < 4; ++m)
#pragma unroll
                for (int n = 0; n < 2; ++n) acc[a][b][m][n] = (f32x4){0.f, 0.f, 0.f, 0.f};
    bf16x8 At[4][2], B0[2][2], B1[2][2];
    const char* cA = (const char*)g.A + (size_t)cur.pm * tstep; const char* cB = (const char*)g.Bt + (size_t)cur.pn * tstep;
    PG8_STAGE(PG8_SB(0, 0), cB, voffB); PG8_STAGE(PG8_SB(0, 1), cB + hstep, voffB); PG8_STAGE(PG8_SA(0, 0), cA, voffA); PG8_STAGE(PG8_SA(0, 1), cA + hstep, voffA);
    if (wr == 1) PG8_BAR;
    PG8_WAIT_V(2); PG8_BAR;
    PG8_STAGE(PG8_SB(1, 0), cB + kstep, voffB); PG8_STAGE(PG8_SA(1, 0), cA + kstep, voffA); PG8_STAGE(PG8_SB(1, 1), cB + hstep + kstep, voffB);
    PG8_WAIT_V(6); PG8_BAR;
    for (;;) {
        const bool has_next = S.next(ui + 1, nxt);
        const char* nA = has_next ? (const char*)g.A + (size_t)nxt.pm * tstep : cA; const char* nB = has_next ? (const char*)g.Bt + (size_t)nxt.pn * tstep : cB;
#pragma unroll 1
        for (int t = 0; t < nt; t += 2) {
            const bool last = (t == nt - 2);
            const char* a1 = cA + (size_t)(t + 1) * kstep;
            const char* a2 = last ? nA : cA + (size_t)(t + 2) * kstep; const char* b2 = last ? nB : cB + (size_t)(t + 2) * kstep;
            const char* a3 = a2 + kstep; const char* b3 = b2 + kstep;
            if constexpr (Epi::MID) { if (t == (nt >> 1)) E.mid(acc, ui, wr, wc, fr, fq); }
            PG8_LDB(B0, 0, 0); PG8_LDB(B1, 0, 1); PG8_SCHED; PG8_LDA(At, 0, 0); PG8_STAGE(PG8_SA(1, 1), a1 + hstep, voffA);
            PG8_WAIT_V(8); PG8_WAIT_L(0); PG8_BAR; PG8_MMA(0, 0, At, B0); PG8_MMA(0, 1, At, B1); PG8_BAR; PG8_SCHED;
            PG8_LDA(At, 0, 1); PG8_STAGE(PG8_SB(0, 0), b2, voffB); PG8_STAGE(PG8_SB(0, 1), b2 + hstep, voffB); PG8_STAGE(PG8_SA(0, 0), a2, voffA);
            PG8_WAIT_V(8); PG8_WAIT_L(0); PG8_BAR; PG8_MMA(1, 0, At, B0); PG8_MMA(1, 1, At, B1); PG8_BAR; PG8_SCHED;
            PG8_LDB(B0, 1, 0); PG8_LDB(B1, 1, 1); PG8_SCHED; PG8_LDA(At, 1, 0); PG8_STAGE(PG8_SA(0, 1), a2 + hstep, voffA);
            PG8_WAIT_V(8); PG8_WAIT_L(0); PG8_BAR; PG8_MMA(0, 0, At, B0); PG8_MMA(0, 1, At, B1); PG8_BAR; PG8_SCHED;
            PG8_LDA(At, 1, 1); PG8_STAGE(PG8_SB(1, 0), b3, voffB); PG8_STAGE(PG8_SB(1, 1), b3 + hstep, voffB); PG8_STAGE(PG8_SA(1, 0), a3, voffA);
            PG8_WAIT_V(8); PG8_WAIT_L(0); PG8_BAR; PG8_MMA(1, 0, At, B0); PG8_MMA(1, 1, At, B1); PG8_BAR; PG8_SCHED;
        }
        if (wr == 0) PG8_BAR;
        E(acc, cur, ui, wr, wc, fr, fq);
        if (!has_next) break;
#pragma unroll
        for (int a = 0; a < 2; ++a)
#pragma unroll
            for (int b = 0; b < 2; ++b)
#pragma unroll
                for (int m = 0; m < 4; ++m)
#pragma unroll
                    for (int n = 0; n < 2; ++n) acc[a][b][m][n] = (f32x4){0.f, 0.f, 0.f, 0.f};
        cur = nxt; cA = nA; cB = nB; ++ui;
        if (wr == 1) PG8_BAR;
    }
    PG8_WAIT_V(0);
    PG8_BAR;
#undef PG8_SA
#undef PG8_SB
#undef PG8_STAGE
#undef PG8_LDA
#undef PG8_LDB
#undef PG8_MMA
#undef PG8_WAIT_V
#undef PG8_WAIT_L
#undef PG8_BAR
#undef PG8_SCHED
}

typedef f32x4 Acc[2][2][4][2];

struct EpiInProj {
    static constexpr bool PERM = true, MID = false;
    const ssq_t* ssq; bf16_t *UG, *Q, *K, *V; const LAS float* tab;
    __device__ __forceinline__ void operator()(const Acc& acc, const Unit& u, int ui, int wr, int wc, int fr, int fq) const {
        const int row0 = u.pm * BM + wr * 64 + fr;
#pragma unroll
        for (int ai = 0; ai < 2; ++ai)
#pragma unroll
            for (int m = 0; m < 4; ++m) {
                const int row = row0 + ai * HALF + m * 16;
                const float rs = tab ? tab[ui * 256 + wr * 64 + fr + ai * HALF + m * 16] : rsqrtf(ssq_get(ssq + row) * (1.f / 1024.f) + EPS);
#pragma unroll
                for (int bj = 0; bj < 2; ++bj) {
                    const int c = u.pn * BM + bj * HALF + wc * 32 + 8 * fq;
                    float sc = rs; bf16_t* dst;
                    if (c < 512) dst = UG + ((size_t)(c >> 4) * MTOK + row) * 16 + (c & 15);
                    else if (c < 1024) { dst = Q + (size_t)row * 512 + (c - 512); sc *= QSCALE; }
                    else if (c < 1152) dst = K + (size_t)row * 128 + (c - 1024);
                    else dst = V + (size_t)row * 128 + (c - 1152);
                    const f32x4 v0 = acc[ai][bj][m][0] * sc, v1 = acc[ai][bj][m][1] * sc;
                    u32x4 w; w.x = cvt_pk_bf16(v0[0], v0[1]); w.y = cvt_pk_bf16(v0[2], v0[3]); w.z = cvt_pk_bf16(v1[0], v1[1]); w.w = cvt_pk_bf16(v1[2], v1[3]);
                    st16(dst, w);
                }
            }
    }
};

struct EpiGlu {
    static constexpr bool PERM = true, MID = false;
    const bf16_t* YG; bf16_t* MIX; ssq_t* ssq;
    __device__ __forceinline__ void operator()(const Acc& acc, const Unit& u, int ui, int wr, int wc, int fr, int fq) const {
        const int row0 = u.pm * BM + wr * 64 + fr;
#pragma unroll
        for (int ai = 0; ai < 2; ++ai)
#pragma unroll
            for (int m = 0; m < 4; ++m) {
                const int row = row0 + ai * HALF + m * 16; float part = 0.f;
#pragma unroll
                for (int bj = 0; bj < 2; ++bj) {
                    const int c = u.pn * BM + bj * HALF + wc * 32 + 8 * fq;
                    const u32x4 yw = *(const u32x4*)(YG + (size_t)row * 512 + c);
                    const f32x4 z0 = acc[ai][bj][m][0], z1 = acc[ai][bj][m][1];
                    float o[8];
                    o[0] = bflo(yw.x) * sigm(z0[0]); o[1] = bfhi(yw.x) * sigm(z0[1]); o[2] = bflo(yw.y) * sigm(z0[2]); o[3] = bfhi(yw.y) * sigm(z0[3]);
                    o[4] = bflo(yw.z) * sigm(z1[0]); o[5] = bfhi(yw.z) * sigm(z1[1]); o[6] = bflo(yw.w) * sigm(z1[2]); o[7] = bfhi(yw.w) * sigm(z1[3]);
#pragma unroll
                    for (int j = 0; j < 8; ++j) part += o[j] * o[j];
                    u32x4 w; w.x = cvt_pk_bf16(o[0], o[1]); w.y = cvt_pk_bf16(o[2], o[3]); w.z = cvt_pk_bf16(o[4], o[5]); w.w = cvt_pk_bf16(o[6], o[7]);
                    st16(MIX + (size_t)row * 1024 + c, w);
                }
                part += __shfl_xor(part, 16); part += __shfl_xor(part, 32);
                if (fq == 0) ssq_add(ssq + row, part);
            }
    }
};

struct EpiPlain {
    static constexpr bool PERM = true, MID = false;
    bf16_t* O;
    __device__ __forceinline__ void operator()(const Acc& acc, const Unit& u, int ui, int wr, int wc, int fr, int fq) const {
        const int row0 = u.pm * BM + wr * 64 + fr;
#pragma unroll
        for (int ai = 0; ai < 2; ++ai)
#pragma unroll
            for (int m = 0; m < 4; ++m) {
                const int row = row0 + ai * HALF + m * 16;
#pragma unroll
                for (int bj = 0; bj < 2; ++bj) {
                    const int c = u.pn * BM + bj * HALF + wc * 32 + 8 * fq;
                    const f32x4 v0 = acc[ai][bj][m][0], v1 = acc[ai][bj][m][1];
                    u32x4 w; w.x = cvt_pk_bf16(v0[0], v0[1]); w.y = cvt_pk_bf16(v0[2], v0[3]); w.z = cvt_pk_bf16(v1[0], v1[1]); w.w = cvt_pk_bf16(v1[2], v1[3]);
                    st16(O + (size_t)row * 1024 + c, w);
                }
            }
    }
};

struct EpiFfnIn {
    static constexpr bool PERM = true, MID = false;
    const ssq_t* ssq; bf16_t* HID; const LAS float* tab;
    __device__ __forceinline__ void operator()(const Acc& acc, const Unit& u, int ui, int wr, int wc, int fr, int fq) const {
        const int row0 = u.pm * BM + wr * 64 + fr; const int c = u.pn * HALF + wc * 32 + 8 * fq;
#pragma unroll
        for (int ai = 0; ai < 2; ++ai)
#pragma unroll
            for (int m = 0; m < 4; ++m) {
                const int row = row0 + ai * HALF + m * 16;
                const float rs = tab ? tab[ui * 256 + wr * 64 + fr + ai * HALF + m * 16] : rsqrtf(ssq_get(ssq + row) * (1.f / 1024.f) + EPS);
                const float c1 = -LOG2E * rs, c2 = rs * rs;
                float o[8];
#pragma unroll
                for (int n = 0; n < 2; ++n)
#pragma unroll
                    for (int j = 0; j < 4; j += 2) { const f32x2 g2 = {acc[ai][0][m][n][j], acc[ai][0][m][n][j + 1]}, u2 = {acc[ai][1][m][n][j], acc[ai][1][m][n][j + 1]};
                        const f32x2 ea = g2 * c1; f32x2 dn; dn.x = __builtin_amdgcn_exp2f(ea.x); dn.y = __builtin_amdgcn_exp2f(ea.y); dn = dn + 1.0f;
                        f32x2 rc; rc.x = __builtin_amdgcn_rcpf(dn.x); rc.y = __builtin_amdgcn_rcpf(dn.y);
                        const f32x2 r2 = (g2 * u2) * (rc * c2); o[n * 4 + j] = r2.x; o[n * 4 + j + 1] = r2.y; }
                u32x4 w; w.x = cvt_pk_bf16(o[0], o[1]); w.y = cvt_pk_bf16(o[2], o[3]); w.z = cvt_pk_bf16(o[4], o[5]); w.w = cvt_pk_bf16(o[6], o[7]);
                st16(HID + (size_t)row * FFH + c, w);
            }
    }
};

template <int MODE> struct EpiRes {
    static constexpr bool PERM = true, MID = (MODE == 1);
    const bf16_t* HR; bf16_t* HW; ssq_t* ssq_out; const ssq_t* ssq_a; const bf16_t* PP; const LAS f32x2* fac; const LAS float* tab;
    __device__ __forceinline__ void mid(Acc& acc, int ui, int wr, int wc, int fr, int fq) const {
        const LAS f32x2* T = fac + (ui & 3) * 256 + wr * 64 + fr;
#pragma unroll
        for (int ai = 0; ai < 2; ++ai)
#pragma unroll
            for (int m = 0; m < 4; ++m) {
                const float f = T[ai * HALF + m * 16].x;
#pragma unroll
                for (int bj = 0; bj < 2; ++bj)
#pragma unroll
                    for (int n = 0; n < 2; ++n) acc[ai][bj][m][n] = acc[ai][bj][m][n] * f;
            }
    }
    __device__ __forceinline__ void operator()(const Acc& acc, const Unit& u, int ui, int wr, int wc, int fr, int fq) const {
        const int row0 = u.pm * BM + wr * 64 + fr; const int col0 = u.pn * BM + wc * 32 + 8 * fq;
        constexpr int NB = (MODE == 2) ? 2 : 4;
#pragma unroll
        for (int g0 = 0; g0 < 8; g0 += NB) {
            u32x4 hw[NB][2], pw[(MODE == 2) ? NB : 1][2]; float rs[NB];
#pragma unroll
            for (int gi = 0; gi < NB; ++gi) { const int g = g0 + gi, ai = g >> 2, m = g & 3;
                const int row = row0 + ai * HALF + m * 16; const size_t off = (size_t)row * 1024 + col0;
#pragma unroll
                for (int bj = 0; bj < 2; ++bj) { hw[gi][bj] = *(const u32x4*)(HR + off + bj * HALF); if (MODE == 2) pw[gi][bj] = *(const u32x4*)(PP + off + bj * HALF); }
                rs[gi] = 1.f;
                if (MODE == 1) rs[gi] = fac[(ui & 3) * 256 + wr * 64 + fr + ai * HALF + m * 16].y;
                if (MODE == 2) rs[gi] = tab ? tab[ui * 256 + wr * 64 + fr + ai * HALF + m * 16] : rsqrtf(ssq_get(ssq_a + row) * (1.f / 1024.f) + EPS);
            }
#pragma unroll
            for (int gi = 0; gi < NB; ++gi) { const int g = g0 + gi, ai = g >> 2, m = g & 3;
                const int row = row0 + ai * HALF + m * 16; const size_t off = (size_t)row * 1024 + col0; float part = 0.f;
                const float r = rs[gi];
#pragma unroll
                for (int bj = 0; bj < 2; ++bj) {
                    const size_t o2 = off + bj * HALF;
                    const u32x4 h4 = hw[gi][bj];
                    const f32x4 a0 = acc[ai][bj][m][0], a1 = acc[ai][bj][m][1];
                    float d[8] = {a0[0], a0[1], a0[2], a0[3], a1[0], a1[1], a1[2], a1[3]};
                    if (MODE == 1) {
#pragma unroll
                        for (int j = 0; j < 8; ++j) d[j] *= r;
                    }
                    if (MODE == 2) { const u32x4 p4 = pw[gi][bj];
                        const float pp[8] = {bflo(p4.x), bfhi(p4.x), bflo(p4.y), bfhi(p4.y), bflo(p4.z), bfhi(p4.z), bflo(p4.w), bfhi(p4.w)};
#pragma unroll
                        for (int j = 0; j < 8; ++j) d[j] = sigm(d[j] * r) * pp[j]; }
                    float o[8];
                    o[0] = bflo(h4.x) + d[0]; o[1] = bfhi(h4.x) + d[1]; o[2] = bflo(h4.y) + d[2]; o[3] = bfhi(h4.y) + d[3];
                    o[4] = bflo(h4.z) + d[4]; o[5] = bfhi(h4.z) + d[5]; o[6] = bflo(h4.w) + d[6]; o[7] = bfhi(h4.w) + d[7];
                    u32x4 w; w.x = cvt_pk_bf16(o[0], o[1]); w.y = cvt_pk_bf16(o[2], o[3]); w.z = cvt_pk_bf16(o[4], o[5]); w.w = cvt_pk_bf16(o[6], o[7]);
                    st16(HW + o2, w);
#pragma unroll
                    for (int j = 0; j < 8; ++j) part += o[j] * o[j];
                }
                part += __shfl_xor(part, 16); part += __shfl_xor(part, 32);
                if (fq == 0) ssq_add(ssq_out + row, part);
            }
            asm volatile("" ::: "memory");
        }
    }
};
}

struct Args { const float* in[24]; float* out; unsigned char* ws; int ph_lo, ph_hi; };
enum { I_X = 0, I_P, I_NMIX, I_WIN, I_ARE, I_AIM, I_LDT, I_BRE, I_BIM, I_CRE, I_CIM, I_D, I_WGLU, I_SINK, I_NSSM, I_NATT, I_WOUT, I_NFFN, I_WFI, I_WFO, I_NPLE, I_WG, I_WP, I_NFIN };

__device__ __forceinline__ ssq_t* ssq_ptr(unsigned char* ws, int l, int type) { return (ssq_t*)(ws + WS_SSQ) + ((size_t)l * 6 + type) * MTOK; }

__device__ __forceinline__ void tr_item(const float* W, int K, int N, bf16_t* WT, const float* s0, const float* s1, int ksplit, bool ffn_map, LAS float* scr, int item, int lane) {
    const int nblk = N / 32, kb = item / nblk, nb = item % nblk, k0 = 64 * kb, n0 = 32 * nb;
    float wv[32];
#pragma unroll
    for (int i = 0; i < 32; ++i) { const int kk = 2 * i + (lane >> 5); wv[i] = W[(size_t)(k0 + kk) * N + n0 + (lane & 31)]; }
    if (s0) {
#pragma unroll
        for (int i = 0; i < 32; ++i) { const int k = k0 + 2 * i + (lane >> 5); const float* sp = (k < ksplit) ? (s0 + k) : (s1 + (k - ksplit)); wv[i] *= *sp; } }
#pragma unroll
    for (int i = 0; i < 32; ++i) { const int kk = 2 * i + (lane >> 5); scr[kk * 33 + (lane & 31)] = wv[i]; }
    LDS_WAIT();
    int nr0 = n0;
    if (ffn_map) { if (n0 < FFH) nr0 = 256 * (n0 / 128) + (n0 % 128); else { const int j = n0 - FFH; nr0 = 256 * (j / 128) + 128 + (j % 128); } }
    const int c = lane & 7;
#pragma unroll
    for (int j = 0; j < 4; ++j) { const int n = (lane >> 3) + 8 * j; const LAS float* s = scr + (8 * c) * 33 + n;
        u32x4 o; o.x = cvt_pk_bf16(s[0 * 33], s[1 * 33]); o.y = cvt_pk_bf16(s[2 * 33], s[3 * 33]); o.z = cvt_pk_bf16(s[4 * 33], s[5 * 33]); o.w = cvt_pk_bf16(s[6 * 33], s[7 * 33]);
        *(u32x4*)(WT + (size_t)(nr0 + n) * K + k0 + 8 * c) = o; }
    LDS_WAIT();
}

__device__ __forceinline__ float wave_sum(float v) {
#pragma unroll
    for (int o = 1; o < 64; o <<= 1) v += __shfl_xor(v, o);
    return v;
}

__device__ __forceinline__ void sincos_acc(float x, float& s, float& c) {
    const float nf = rintf(x * 0.6366197723675814f); const int n = (int)nf;
    float r = __builtin_fmaf(nf, -1.5707962513e+00f, x); r = __builtin_fmaf(nf, -7.5497894159e-08f, r); r = __builtin_fmaf(nf, -5.3903029534e-15f, r);
    const float r2 = r * r;
    float sp = __builtin_fmaf(r2, 2.7557319224e-06f, -1.9841269841e-04f); sp = __builtin_fmaf(sp, r2, 8.3333333333e-03f); sp = __builtin_fmaf(sp, r2, -1.6666666667e-01f); sp = __builtin_fmaf(sp * r2, r, r);
    float cp = __builtin_fmaf(r2, -2.7557319224e-07f, 2.4801587302e-05f); cp = __builtin_fmaf(cp, r2, -1.3888888889e-03f); cp = __builtin_fmaf(cp, r2, 4.1666666667e-02f); cp = __builtin_fmaf(cp, r2, -0.5f); cp = __builtin_fmaf(cp, r2, 1.0f);
    const int q = n & 3;
    const float ss = (q & 1) ? cp : sp, cc = (q & 1) ? sp : cp;
    s = (q & 2) ? -ss : ss; c = ((q + 1) & 2) ? -cc : cc;
}

__device__ __forceinline__ void prologue(const Args& a, LAS unsigned char* lds, unsigned char* ws) {
    const int tid = opaque_tid(), lane = tid & 63, wave = tid >> 6;
    const int G = gridDim.x, gw = blockIdx.x * 8 + wave, NGW = G * 8;
    const int gtid = blockIdx.x * 512 + tid, NT = G * 512;
    LAS float* scr = (LAS float*)(lds + wave * 16384);
    constexpr int IT_IN = 16 * 40, IT_GLU = 8 * 16, IT_OUT = 16 * 32, IT_FI = 16 * 176, IT_FO = 44 * 32, IT_G = 16 * 32, IT_P = 4 * 32;
    constexpr int IT_L = IT_IN + IT_GLU + IT_OUT + IT_FI + IT_FO + IT_G + IT_P;
    for (int it = gw; it < IT_L * DEPTH; it += NGW) {
        const int l = it / IT_L; int r = it % IT_L;
        unsigned char* wl = ws + WS_W + (size_t)l * W_LAYER;
        if (r < IT_IN) { tr_item(a.in[I_WIN] + (size_t)l * DM * INW, DM, INW, (bf16_t*)(wl + WO_IN), a.in[I_NMIX] + l * DM, a.in[I_NMIX] + l * DM, DM, false, scr, r, lane); continue; } r -= IT_IN;
        if (r < IT_GLU) { tr_item(a.in[I_WGLU] + (size_t)l * SSMW * SSMW, SSMW, SSMW, (bf16_t*)(wl + WO_GLU), nullptr, nullptr, 0, false, scr, r, lane); continue; } r -= IT_GLU;
        if (r < IT_OUT) { tr_item(a.in[I_WOUT] + (size_t)l * DM * DM, DM, DM, (bf16_t*)(wl + WO_OUT), a.in[I_NSSM] + l * SSMW, a.in[I_NATT] + l * ATTW, SSMW, false, scr, r, lane); continue; } r -= IT_OUT;
        if (r < IT_FI) { tr_item(a.in[I_WFI] + (size_t)l * DM * 2 * FFH, DM, 2 * FFH, (bf16_t*)(wl + WO_FI), a.in[I_NFFN] + l * DM, a.in[I_NFFN] + l * DM, DM, true, scr, r, lane); continue; } r -= IT_FI;
        if (r < IT_FO) { tr_item(a.in[I_WFO] + (size_t)l * FFH * DM, FFH, DM, (bf16_t*)(wl + WO_FO), nullptr, nullptr, 0, false, scr, r, lane); continue; } r -= IT_FO;
        if (r < IT_G) { tr_item(a.in[I_WG] + (size_t)l * DM * DM, DM, DM, (bf16_t*)(wl + WO_G), a.in[I_NPLE] + l * DM, a.in[I_NPLE] + l * DM, DM, false, scr, r, lane); continue; } r -= IT_G;
        tr_item(a.in[I_WP] + (size_t)l * PLE * DM, PLE, DM, (bf16_t*)(wl + WO_P), nullptr, nullptr, 0, false, scr, r, lane);
    }
    {
        ssq_t* ssq0 = ssq_ptr(ws, 0, 0); bf16_t* HB = (bf16_t*)(ws + WS_HB);
        for (int m = gw; m < MTOK; m += 2 * NGW) {
            const int m2 = m + NGW;
            const bool has2 = m2 < MTOK; const int mm2 = has2 ? m2 : m;
            const f32x4* xr = (const f32x4*)(a.in[I_X] + (size_t)m * DM) + lane; const f32x4* xr2 = (const f32x4*)(a.in[I_X] + (size_t)mm2 * DM) + lane;
            f32x4 v[4], v2[4];
#pragma unroll
            for (int j = 0; j < 4; ++j) { v[j] = xr[64 * j]; v2[j] = xr2[64 * j]; }
            u32x2* hb = (u32x2*)(HB + (size_t)m * DM) + lane; u32x2* hb2 = (u32x2*)(HB + (size_t)mm2 * DM) + lane;
            float s = 0.f, s2 = 0.f;
#pragma unroll
            for (int j = 0; j < 4; ++j) { u32x2 w; w.x = cvt_pk_bf16(v[j][0], v[j][1]); w.y = cvt_pk_bf16(v[j][2], v[j][3]); hb[64 * j] = w; s += (v[j][0] * v[j][0] + v[j][1] * v[j][1]) + (v[j][2] * v[j][2] + v[j][3] * v[j][3]);
                u32x2 w2; w2.x = cvt_pk_bf16(v2[j][0], v2[j][1]); w2.y = cvt_pk_bf16(v2[j][2], v2[j][3]); if (has2) hb2[64 * j] = w2; s2 += (v2[j][0] * v2[j][0] + v2[j][1] * v2[j][1]) + (v2[j][2] * v2[j][2] + v2[j][3] * v2[j][3]); }
            s = wave_sum(s); s2 = wave_sum(s2);
            if (lane == 0) { ssq0[m] = (ssq_t)(s * 268435456.f); if (has2) ssq0[m2] = (ssq_t)(s2 * 268435456.f); }
        }
    }
    {
        const f32x4* p4 = (const f32x4*)a.in[I_P]; u32x4* pb = (u32x4*)(ws + WS_PB);
        const int n8 = DEPTH * MTOK * PLE / 8;
#pragma unroll 4
        for (int i = gtid; i < n8; i += NT) { const f32x4 v0 = p4[2 * i], v1 = p4[2 * i + 1]; u32x4 w; w.x = cvt_pk_bf16(v0[0], v0[1]); w.y = cvt_pk_bf16(v0[2], v0[3]); w.z = cvt_pk_bf16(v1[0], v1[1]); w.w = cvt_pk_bf16(v1[2], v1[3]); pb[i] = w; }
    }
    {
        u32x4* z = (u32x4*)(ws + WS_SSQ); const int n4 = DEPTH * 6 * MTOK / 2;
        for (int i = gtid; i < n4; i += NT) if (i >= MTOK / 2) z[i] = (u32x4){0u, 0u, 0u, 0u};
    }
    if (gtid < DEPTH * NG * NS) {
        const int l = gtid >> 11, g = (gtid >> 6) & 31, p = gtid & 63, lg = l * NG + g;
        const float dt = __expf(a.in[I_LDT][lg]);
        const float ar = a.in[I_ARE][lg * NS + p], ai = a.in[I_AIM][lg * NS + p];
        const float mag = __expf(ar * dt); float sn, cs; sincos_acc(ai * dt, sn, cs);
        const float lr = mag * cs, li = mag * sn;
        const float den = ar * ar + ai * ai, nr = lr - 1.f, ni = li;
        const float fr = (nr * ar + ni * ai) / den, fi = (ni * ar - nr * ai) / den;
        bf16_t* Bm = (bf16_t*)(ws + WS_BMAT) + (size_t)lg * 128 * 16; bf16_t* Cm = (bf16_t*)(ws + WS_CMAT) + (size_t)lg * 16 * 128;
        const float* bre = a.in[I_BRE] + ((size_t)lg * NS + p) * 16; const float* bim = a.in[I_BIM] + ((size_t)lg * NS + p) * 16;
#pragma unroll
        for (int h = 0; h < 16; ++h) { const float br = bre[h], bi = bim[h];
            Bm[p * 16 + h] = (bf16_t)f2bf(fr * br - fi * bi); Bm[(64 + p) * 16 + h] = (bf16_t)f2bf(fr * bi + fi * br);
            Cm[h * 128 + 2 * p] = (bf16_t)f2bf(a.in[I_CRE][((size_t)lg * 16 + h) * NS + p]); Cm[h * 128 + 2 * p + 1] = (bf16_t)f2bf(-a.in[I_CIM][((size_t)lg * 16 + h) * NS + p]); }
        f32x2* lam = (f32x2*)(ws + WS_LAM); lam[lg * NS + p] = (f32x2){lr, li};
    }
}

constexpr int SSM_BU = 0, SSM_BU_STRIDE = 260;
constexpr int SSM_X = 0, SSM_X_STRIDE = 272;
constexpr int SSM_E = 128 * 260 * 4;
constexpr int SSM_U = SSM_E + 8 * 64 * 8;
static_assert(SSM_U + 256 * 32 <= LDS_BAR_OFF && 256 * SSM_X_STRIDE <= SSM_E, "S5 LDS map");
__device__ __forceinline__ void ssm_item(LAS unsigned char* lds, int b, int g, int l, const Args& a, unsigned char* ws) {
    const int tid = opaque_tid(), lane = tid & 63, w = __builtin_amdgcn_readfirstlane(tid >> 6), fr = lane & 15, fq = lane >> 4;
    const int lg = l * NG + g;
    const bf16_t* UGg = (const bf16_t*)(ws + WS_UG) + ((size_t)g * MTOK + (size_t)b * SEQ) * 16;
    const bf16_t* Bm = (const bf16_t*)(ws + WS_BMAT) + (size_t)lg * 128 * 16; const bf16_t* Cm = (const bf16_t*)(ws + WS_CMAT) + (size_t)lg * 16 * 128;
    bf16_t* YG = (bf16_t*)(ws + WS_YG) + (size_t)b * SEQ * 512 + g * 16;
    LAS float* BuS = (LAS float*)(lds + SSM_BU); LAS f32x2* Es = (LAS f32x2*)(lds + SSM_E); LAS unsigned char* XS = lds + SSM_X; LAS unsigned char* US = lds + SSM_U;
    const int p = lane, t0 = 32 * w;
    const bf16x8 zero8 = {0, 0, 0, 0, 0, 0, 0, 0};
    bf16x8 bB[8];
#pragma unroll
    for (int j = 0; j < 8; ++j) { const bf16x8 t = *(const bf16x8*)(Bm + (j * 16 + fr) * 16 + 8 * (fq & 1)); bB[j] = (fq < 2) ? t : zero8; asm volatile("" : "+v"(bB[j])); }
    bf16x8 cB[4];
#pragma unroll
    for (int ks = 0; ks < 4; ++ks) { cB[ks] = *(const bf16x8*)(Cm + fr * 128 + ks * 32 + 8 * fq); asm volatile("" : "+v"(cB[ks])); }
    const float dsk = a.in[I_D][l * SSMW + g * 16 + fr];
    const f32x2 lam = ((const f32x2*)(ws + WS_LAM))[lg * NS + p];
    const float lr = lam.x, li = lam.y;
    const f32x2 lrr = {lr, lr}, lii = {-li, li};
    float l32r = lr, l32i = li;
#pragma unroll
    for (int j = 0; j < 5; ++j) { const float nr = l32r * l32r - l32i * l32i, ni = 2.f * l32r * l32i; l32r = nr; l32i = ni; }
    float xpr = 0.f, xpi = 0.f;
    bf16x8 a_next[2];
#pragma unroll
    for (int i = 0; i < 2; ++i) { const bf16x8 t = *(const bf16x8*)(UGg + (size_t)(t0 + 16 * i + fr) * 16 + 8 * (fq & 1)); a_next[i] = (fq < 2) ? t : zero8; }
#pragma unroll 1
    for (int c = 0; c < SEQ / 256; ++c) {
        bf16x8 a_cur[2] = {a_next[0], a_next[1]};
        { const int cn = (c + 1 < SEQ / 256) ? c + 1 : c;
#pragma unroll
            for (int i = 0; i < 2; ++i) { const bf16x8 t = *(const bf16x8*)(UGg + (size_t)(cn * 256 + t0 + 16 * i + fr) * 16 + 8 * (fq & 1)); a_next[i] = (fq < 2) ? t : zero8; }
        }
#pragma unroll
        for (int i = 0; i < 2; ++i) {
            if (fq < 2) *(LAS bf16x8*)(US + (t0 + 16 * i + fr) * 32 + fq * 16) = a_cur[i];
#pragma unroll
            for (int j = 0; j < 8; ++j) {
                const f32x4 d = __builtin_amdgcn_mfma_f32_16x16x32_bf16(a_cur[i], bB[j], (f32x4){0.f, 0.f, 0.f, 0.f}, 0, 0, 0);
                *(LAS f32x4*)(BuS + (j * 16 + fr) * SSM_BU_STRIDE + t0 + 16 * i + 4 * fq) = d;
            }
        }
        LBAR();
        f32x2 xl[32]; { f32x2 x = {0.f, 0.f};
#pragma unroll
            for (int j4 = 0; j4 < 8; ++j4) { const f32x4 br4 = *(const LAS f32x4*)(BuS + p * SSM_BU_STRIDE + t0 + 4 * j4), bi4 = *(const LAS f32x4*)(BuS + (64 + p) * SSM_BU_STRIDE + t0 + 4 * j4);
#pragma unroll
                for (int r = 0; r < 4; ++r) { const int j = 4 * j4 + r; const f32x2 bb = {br4[r], bi4[r]}; const f32x2 xs = {x.y, x.x};
                    x = lrr * x + (lii * xs + bb); xl[j] = x; } }
            Es[w * 64 + p] = x; }
        LBAR();
        { float cr = xpr, ci = xpi, mr = 0.f, mi = 0.f;
#pragma unroll
            for (int j = 0; j < 8; ++j) { if (j == w) { mr = cr; mi = ci; } const f32x2 e = Es[j * 64 + p];
                const float nr = l32r * cr - l32i * ci + e.x, ni = l32r * ci + l32i * cr + e.y; cr = nr; ci = ni; }
            xpr = cr; xpi = ci;
            f32x2 mm = {mr, mi};
#pragma unroll
            for (int j = 0; j < 32; ++j) { const f32x2 ms = {mm.y, mm.x}; mm = lrr * mm + lii * ms;
                const f32x2 X = xl[j] + mm;
                *(LAS unsigned*)(XS + (t0 + j) * SSM_X_STRIDE + p * 4) = cvt_pk_bf16(X.x, X.y); } }
        LBAR();
#pragma unroll
        for (int i = 0; i < 2; ++i) {
            f32x4 y = (f32x4){0.f, 0.f, 0.f, 0.f};
#pragma unroll
            for (int ks = 0; ks < 4; ++ks) { const bf16x8 xa = *(const LAS bf16x8*)(XS + (t0 + 16 * i + fr) * SSM_X_STRIDE + ks * 64 + fq * 16);
                y = __builtin_amdgcn_mfma_f32_16x16x32_bf16(xa, cB[ks], y, 0, 0, 0); }
#pragma unroll
            for (int r = 0; r < 4; ++r) { const int tl = t0 + 16 * i + 4 * fq + r;
                const float uu = bflo((unsigned)*(const LAS bf16_t*)(US + tl * 32 + fr * 2));
                const float v = y[r] + dsk * uu;
                const float o = v * sigm(1.5957691216f * (v + 0.044715f * v * v * v));
                YG[(size_t)(c * 256 + tl) * 512 + fr] = (bf16_t)(cvt_pk_bf16(o, 0.f) & 0xffffu); }
        }
        LBAR();
    }
    __syncthreads();
}

constexpr int ATT_KS = 0, ATT_K_STRIDE = 272;
constexpr int ATT_VT = 256 * 272, ATT_V_STRIDE = 528;
static_assert(ATT_VT + 128 * ATT_V_STRIDE <= LDS_BYTES, "attention LDS");
__device__ __forceinline__ void attn_item(LAS unsigned char* lds, int b, int nb, int l, const Args& a, unsigned char* ws, int ssq_type = 2) {
    const int tid = opaque_tid(), lane = tid & 63, w = __builtin_amdgcn_readfirstlane(tid >> 6), fr = lane & 15, fq = lane >> 4;
    const bf16_t* Qg = (const bf16_t*)(ws + WS_Q); const bf16_t* Kg = (const bf16_t*)(ws + WS_K); const bf16_t* Vg = (const bf16_t*)(ws + WS_V);
    bf16_t* MIX = (bf16_t*)(ws + WS_MIX); ssq_t* ssq_att = ssq_ptr(ws, l, ssq_type);
    const int row0 = b * SEQ + nb * 128;
    const int krow0 = row0 - 128;
#pragma unroll
    for (int i = 0; i < 8; ++i) { const int pi = tid + i * 512, r = pi >> 4, cp = pi & 15;
        const bool ok = (nb > 0 || r >= 128);
        u32x4 v = *(const u32x4*)(Kg + (size_t)(ok ? krow0 + r : row0) * 128 + cp * 8);
        if (!ok) v = (u32x4){0u, 0u, 0u, 0u};
        *(LAS u32x4*)(lds + ATT_KS + r * ATT_K_STRIDE + cp * 16) = v; }
#pragma unroll
    for (int i = 0; i < 8; ++i) { const int pi = tid + i * 512, r = pi & 255, cp = pi >> 8;
        const bool ok = (nb > 0 || r >= 128);
        u32x4 v = *(const u32x4*)(Vg + (size_t)(ok ? krow0 + r : row0) * 128 + cp * 8);
        if (!ok) v = (u32x4){0u, 0u, 0u, 0u};
        LAS unsigned char* vb = lds + ATT_VT + (cp * 8) * ATT_V_STRIDE + r * 2;
        *(LAS bf16_t*)(vb + 0 * ATT_V_STRIDE) = (bf16_t)(v.x & 0xffffu); *(LAS bf16_t*)(vb + 1 * ATT_V_STRIDE) = (bf16_t)(v.x >> 16);
        *(LAS bf16_t*)(vb + 2 * ATT_V_STRIDE) = (bf16_t)(v.y & 0xffffu); *(LAS bf16_t*)(vb + 3 * ATT_V_STRIDE) = (bf16_t)(v.y >> 16);
        *(LAS bf16_t*)(vb + 4 * ATT_V_STRIDE) = (bf16_t)(v.z & 0xffffu); *(LAS bf16_t*)(vb + 5 * ATT_V_STRIDE) = (bf16_t)(v.z >> 16);
        *(LAS bf16_t*)(vb + 6 * ATT_V_STRIDE) = (bf16_t)(v.w & 0xffffu); *(LAS bf16_t*)(vb + 7 * ATT_V_STRIDE) = (bf16_t)(v.w >> 16); }
    __syncthreads();
    const int h = w, kvh = w >> 2;
    const float sink2 = a.in[I_SINK][l * 8 + h] * LOG2E;
    const float NEG = -__builtin_inff();
    bf16x8 qn0 = *(const bf16x8*)(Qg + (size_t)(row0 + fr) * 512 + h * 64 + 8 * fq), qn1 = *(const bf16x8*)(Qg + (size_t)(row0 + fr) * 512 + h * 64 + 32 + 8 * fq);
    for (int qt = 0; qt < 8; ++qt) {
        const bf16x8 q0 = qn0, q1 = qn1;
        if (qt < 7) { qn0 = *(const bf16x8*)(Qg + (size_t)(row0 + (qt + 1) * 16 + fr) * 512 + h * 64 + 8 * fq); qn1 = *(const bf16x8*)(Qg + (size_t)(row0 + (qt + 1) * 16 + fr) * 512 + h * 64 + 32 + 8 * fq); }
        f32x4 s[9];
#pragma unroll
        for (int i = 0; i < 9; ++i) {
            const LAS unsigned char* kp = lds + ATT_KS + (16 * (qt + i) + fr) * ATT_K_STRIDE + kvh * 128 + fq * 16;
            const bf16x8 k0 = *(const LAS bf16x8*)kp, k1 = *(const LAS bf16x8*)(kp + 64);
            f32x4 d = __builtin_amdgcn_mfma_f32_16x16x32_bf16(k0, q0, (f32x4){0.f, 0.f, 0.f, 0.f}, 0, 0, 0);
            s[i] = __builtin_amdgcn_mfma_f32_16x16x32_bf16(k1, q1, d, 0, 0, 0);
        }
#pragma unroll
        for (int r = 0; r < 4; ++r) { if (!(4 * fq + r > fr)) s[0][r] = NEG; if (!(4 * fq + r <= fr)) s[8][r] = NEG; }
        if (nb == 0) {
#pragma unroll
            for (int i = 0; i < 8; ++i) if (i < 8 - qt) s[i] = (f32x4){NEG, NEG, NEG, NEG};
        }
        float mx = sink2;
#pragma unroll
        for (int i = 0; i < 9; ++i) mx = fmaxf(mx, fmaxf(fmaxf(s[i][0], s[i][1]), fmaxf(s[i][2], s[i][3])));
        mx = fmaxf(mx, __shfl_xor(mx, 16)); mx = fmaxf(mx, __shfl_xor(mx, 32));
        float sum = 0.f;
#pragma unroll
        for (int i = 0; i < 9; ++i)
#pragma unroll
            for (int r = 0; r < 4; ++r) { const float e = __builtin_amdgcn_exp2f(s[i][r] - mx); s[i][r] = e; sum += e; }
        sum += __shfl_xor(sum, 16); sum += __shfl_xor(sum, 32);
        sum += __builtin_amdgcn_exp2f(sink2 - mx);
        const float inv = __builtin_amdgcn_rcpf(sum);
        f32x4 o[4];
#pragma unroll
        for (int dt = 0; dt < 4; ++dt) o[dt] = (f32x4){0.f, 0.f, 0.f, 0.f};
#pragma unroll
        for (int i = 0; i < 8; i += 2) {
            u32x4 pw; pw.x = cvt_pk_bf16(s[i][0], s[i][1]); pw.y = cvt_pk_bf16(s[i][2], s[i][3]); pw.z = cvt_pk_bf16(s[i + 1][0], s[i + 1][1]); pw.w = cvt_pk_bf16(s[i + 1][2], s[i + 1][3]);
            const bf16x8 pb = __builtin_bit_cast(bf16x8, pw);
#pragma unroll
            for (int dt = 0; dt < 4; ++dt) {
                const LAS unsigned char* vp = lds + ATT_VT + (kvh * 64 + dt * 16 + fr) * ATT_V_STRIDE + (16 * (qt + i) + 4 * fq) * 2;
                const u32x2 va = *(const LAS u32x2*)vp, vb = *(const LAS u32x2*)(vp + 32);
                u32x4 vw; vw.x = va.x; vw.y = va.y; vw.z = vb.x; vw.w = vb.y;
                o[dt] = __builtin_amdgcn_mfma_f32_16x16x32_bf16(__builtin_bit_cast(bf16x8, vw), pb, o[dt], 0, 0, 0);
            }
        }
        {
            u32x2 pw; pw.x = cvt_pk_bf16(s[8][0], s[8][1]); pw.y = cvt_pk_bf16(s[8][2], s[8][3]);
            const bf16x4 pb = __builtin_bit_cast(bf16x4, pw);
#pragma unroll
            for (int dt = 0; dt < 4; ++dt) {
                const LAS unsigned char* vp = lds + ATT_VT + (kvh * 64 + dt * 16 + fr) * ATT_V_STRIDE + (16 * (qt + 8) + 4 * fq) * 2;
                const u32x2 va = *(const LAS u32x2*)vp;
                o[dt] = __builtin_amdgcn_mfma_f32_16x16x16bf16_1k(__builtin_bit_cast(bf16x4, va), pb, o[dt], 0, 0, 0);
            }
        }
        const int row = row0 + qt * 16 + fr; float part = 0.f;
#pragma unroll
        for (int dt = 0; dt < 4; ++dt) { const f32x4 v = o[dt] * inv; part += (v[0] * v[0] + v[1] * v[1]) + (v[2] * v[2] + v[3] * v[3]);
            u32x2 wv; wv.x = cvt_pk_bf16(v[0], v[1]); wv.y = cvt_pk_bf16(v[2], v[3]);
            *(u32x2*)(MIX + (size_t)row * 1024 + 512 + h * 64 + dt * 16 + 4 * fq) = wv; }
        part += __shfl_xor(part, 16); part += __shfl_xor(part, 32);
        if (fq == 0) ssq_add(ssq_att + row, part);
    }
    __syncthreads();
}

#define XB_TMO      128
#define XB_XCNT(j)  (256  + 64 * (j))
#define XB_XSUB(j)  (1280 + 64 * (j))
#define XB_XGEN(j)  (2304 + 64 * (j))
#define XB_TOP      3328
#define XB_TOPGEN   3392
#define XCD_BAR_WORDS 3456
#define XB_SPIN_CAP (1u << 20)
__device__ __forceinline__ unsigned xb_ld(unsigned* p)              { return __hip_atomic_load(p, __ATOMIC_RELAXED, __HIP_MEMORY_SCOPE_AGENT); }
__device__ __forceinline__ unsigned xb_add(unsigned* p, unsigned v) { return __hip_atomic_fetch_add(p, v, __ATOMIC_RELAXED, __HIP_MEMORY_SCOPE_AGENT); }
__device__ __forceinline__ unsigned xb_xcc_id() { return (unsigned)__builtin_amdgcn_s_getreg((3 << 11) | 20) & 0xFu; }
#define XB_SPIN(cond, bar) do { unsigned _sp = 0; while (cond) { __builtin_amdgcn_s_sleep(1); \
    if ((++_sp & 255u) == 0u) { if (xb_ld(&(bar)[XB_TMO])) break; if (_sp > XB_SPIN_CAP) { atomicAdd(&(bar)[XB_TMO], 1u); break; } } } } while (0)
struct XcdBarrier { unsigned* bar; unsigned x; volatile LAS unsigned* st; };
__device__ __forceinline__ XcdBarrier xcd_barrier_post(unsigned* bar, volatile LAS unsigned* st) {
    XcdBarrier b; b.bar = bar; b.x = xb_xcc_id(); b.st = st;
    if (threadIdx.x == 0) (void)xb_add(&bar[XB_XCNT(b.x)], 1u);
    return b;
}
__device__ __forceinline__ void xcd_barrier_complete(unsigned* bar, unsigned x, unsigned& nloc, unsigned& nx) {
    const unsigned G = gridDim.x * gridDim.y * gridDim.z;
    unsigned sum, cnt, mine, sp = 0u;
    for (;;) {
        sum = 0u; cnt = 0u; mine = 0u;
#pragma unroll
        for (unsigned j = 0; j < 16; ++j) { const unsigned c = xb_ld(&bar[XB_XCNT(j)]); sum += c; cnt += (c > 0u) ? 1u : 0u; mine = (j == x) ? c : mine; }
        if (sum == G) break;
        __builtin_amdgcn_s_sleep(1);
        if ((++sp & 255u) == 0u) { if (xb_ld(&bar[XB_TMO])) break; if (sp > XB_SPIN_CAP) { atomicAdd(&bar[XB_TMO], 1u); break; } }
    }
    nloc = mine > 0u ? mine : 1u; nx = cnt > 0u ? cnt : 1u;
}
__device__ __forceinline__ void xcd_barrier(const XcdBarrier& b) {
    asm volatile("s_waitcnt vmcnt(0)" ::: "memory");
    __syncthreads();
    if (threadIdx.x == 0) {
        unsigned* bar = b.bar;
        __builtin_amdgcn_s_waitcnt(0);
        unsigned nloc = b.st[0], nx = b.st[1];
        if (nloc == 0u) { xcd_barrier_complete(bar, b.x, nloc, nx); b.st[0] = nloc; b.st[1] = nx; }
        const unsigned old = xb_add(&bar[XB_XSUB(b.x)], 1u);
        const unsigned gen = old / nloc;
        if (old + 1u == (gen + 1u) * nloc) {
            __builtin_amdgcn_fence(__ATOMIC_RELEASE, "agent");
            asm volatile("s_waitcnt vmcnt(0)" ::: "memory");
            const unsigned og = xb_add(&bar[XB_TOP], 1u);
            const unsigned tg = og / nx;
            if (og + 1u == (tg + 1u) * nx) xb_add(&bar[XB_TOPGEN], 1u);
            else XB_SPIN(xb_ld(&bar[XB_TOPGEN]) == tg, bar);
            __builtin_amdgcn_fence(__ATOMIC_ACQUIRE, "agent");
            xb_add(&bar[XB_XGEN(b.x)], 1u);
            asm volatile("s_waitcnt vmcnt(0)" ::: "memory");
        } else {
            XB_SPIN(xb_ld(&bar[XB_XGEN(b.x)]) == gen, bar);
            __builtin_amdgcn_fence(__ATOMIC_ACQUIRE, "agent");
            asm volatile("s_waitcnt vmcnt(0)" ::: "memory");
        }
    }
    __syncthreads();
}

__device__ __forceinline__ const LAS float* build_rstd_tab(LAS unsigned char* lds, const pg8::StaticOrder& S, const ssq_t* ssq) {
    pg8::Unit uu; if (S.next(15, uu)) return nullptr;
    LAS float* tab = (LAS float*)(lds + LDS_FAC_OFF);
    const int t = opaque_tid();
    for (int i = t >> 8; S.next(i, uu); i += 2) tab[i * 256 + (t & 255)] = rsqrtf(ssq_get(ssq + uu.pm * 256 + (t & 255)) * (1.f / 1024.f) + EPS);
    __syncthreads();
    return tab;
}

__global__ void __launch_bounds__(512, 2) hymba_fwd(Args a_in) {
    extern __shared__ __attribute__((aligned(16))) unsigned char lds_raw[];
    LAS unsigned char* lds = (LAS unsigned char*)lds_raw;
    const int G = gridDim.x, bx = blockIdx.x;
    int ph = a_in.ph_lo; const int ph_hi = a_in.ph_hi;
    volatile LAS unsigned* bst = (volatile LAS unsigned*)(lds + LDS_BAR_OFF);
    if (threadIdx.x < 2) bst[threadIdx.x] = 0u;
    __syncthreads();
#if MK_MULTI
    const XcdBarrier xbar = xcd_barrier_post((unsigned*)(a_in.ws + WS_CTL), bst);
#endif
    if (ph == 0) {
#if !MK_MULTI
        if (bx == 0) { unsigned* bw = (unsigned*)(a_in.ws + WS_CTL); for (int i = threadIdx.x; i < XCD_BAR_WORDS; i += 512) bw[i] = 0u; }
#endif
        if (PH_EN(9)) for (int rep = 0; rep < 1 + ((PROBE_REP >> 2) & 1); ++rep) { prologue(a_in, lds, a_in.ws); __syncthreads(); }
        __syncthreads(); ++ph;
        if (ph < ph_hi) cg::this_grid().sync();
    }
#if !MK_MULTI
    const XcdBarrier xbar = xcd_barrier_post((unsigned*)(a_in.ws + WS_CTL), bst);
#endif
    for (; ph < ph_hi && ph < NPHASE - 1; ++ph) {
        const Args& a = a_in;
        size_t zoff = 0; asm volatile("" : "+s"(zoff));
        unsigned char* ws = a.ws + zoff;
        bf16_t* HB1 = (bf16_t*)a.out + zoff; bf16_t* HB0 = (bf16_t*)(ws + WS_HB);
        const int l = (ph - 1) / 7, j = (ph - 1) % 7;
        unsigned char* wl = ws + WS_W + (size_t)l * W_LAYER;
        pg8::StaticOrder S;
        if (j == 0) { if (PH_EN(0)) {
            pg8::Gemm g{HB0, (const bf16_t*)(wl + WO_IN), MTOK, INW, DM}; S.init(MTOK, INW, G, bx);
            pg8::EpiInProj E{ssq_ptr(ws, l, 0), (bf16_t*)(ws + WS_UG), (bf16_t*)(ws + WS_Q), (bf16_t*)(ws + WS_K), (bf16_t*)(ws + WS_V), build_rstd_tab(lds, S, ssq_ptr(ws, l, 0))};
            pg8::gemm_phase(lds, g, S, E);
            if (PH_EN(4) && G == 256) { pg8::Gemm g2{(const bf16_t*)(ws + WS_PB) + (size_t)l * MTOK * PLE, (const bf16_t*)(wl + WO_P), MTOK, DM, PLE};
              pg8::StaticOrder S2; S2.init(MTOK, DM, 128, bx >= 128 ? bx - 128 : (1 << 20));
              pg8::EpiPlain E2{(bf16_t*)(ws + WS_PP)};
              pg8::gemm_phase(lds, g2, S2, E2); } }
        } else if (j == 1) {
            if (PH_EN(1)) for (int rep = 0; rep < 1 + (PROBE_REP & 1); ++rep) for (int it = bx; it < BATCH * NG; it += G) ssm_item(lds, it >> 5, it & 31, l, a, ws);
            if (PH_EN(2)) for (int rep = 0; rep < 1 + ((PROBE_REP >> 1) & 1); ++rep) for (int it = bx; it < BATCH * (SEQ / 128); it += G) attn_item(lds, it >> 5, it & 31, l, a, ws, rep ? 5 : 2);
        } else if (j == 2) {
            if (PH_EN(3)) { pg8::Gemm g{(const bf16_t*)(ws + WS_YG), (const bf16_t*)(wl + WO_GLU), MTOK, SSMW, SSMW}; S.init(MTOK, SSMW, G, bx);
              pg8::EpiGlu E{(const bf16_t*)(ws + WS_YG), (bf16_t*)(ws + WS_MIX), ssq_ptr(ws, l, 1)};
              pg8::gemm_phase(lds, g, S, E); }
            if (PH_EN(4) && G != 256) { pg8::Gemm g{(const bf16_t*)(ws + WS_PB) + (size_t)l * MTOK * PLE, (const bf16_t*)(wl + WO_P), MTOK, DM, PLE}; S.init(MTOK, DM, G, bx);
              pg8::EpiPlain E{(bf16_t*)(ws + WS_PP)};
              pg8::gemm_phase(lds, g, S, E); }
        } else if (j == 3) { if (PH_EN(5)) {
            pg8::Gemm g{(const bf16_t*)(ws + WS_MIX), (const bf16_t*)(wl + WO_OUT), MTOK, DM, DM}; S.init(MTOK, DM, G, bx);
            LAS f32x2* fac = (LAS f32x2*)(lds + LDS_FAC_OFF);
            { const int t2 = opaque_tid(); const ssq_t* sa = ssq_ptr(ws, l, 1); const ssq_t* sb = ssq_ptr(ws, l, 2); pg8::Unit uu;
              for (int i = 0; i < 4 && S.next(i, uu); ++i) if (t2 < 256) { const int row = uu.pm * 256 + t2;
                  const float rs_s = rsqrtf(ssq_get(sa + row) * (1.f / 512.f) + EPS), rs_a = rsqrtf(ssq_get(sb + row) * (1.f / 512.f) + EPS); fac[i * 256 + t2] = (f32x2){rs_s / rs_a, rs_a}; }
              __syncthreads(); }
            pg8::EpiRes<1> E{HB0, HB1, ssq_ptr(ws, l, 3), nullptr, nullptr, fac, nullptr};
            pg8::gemm_phase(lds, g, S, E); }
        } else if (j == 4) { if (PH_EN(6)) {
            pg8::Gemm g{HB1, (const bf16_t*)(wl + WO_FI), MTOK, 2 * FFH, DM}; S.init(MTOK, 2 * FFH, G, bx);
            pg8::EpiFfnIn E{ssq_ptr(ws, l, 3), (bf16_t*)(ws + WS_HID), build_rstd_tab(lds, S, ssq_ptr(ws, l, 3))};
            for (int rep = 0; rep < 1 + ((PROBE_REP >> 4) & 1); ++rep) pg8::gemm_phase(lds, g, S, E); }
        } else if (j == 5) { if (PH_EN(7)) {
            pg8::Gemm g{(const bf16_t*)(ws + WS_HID), (const bf16_t*)(wl + WO_FO), MTOK, DM, FFH}; S.init(MTOK, DM, G, bx);
            pg8::EpiRes<0> E{HB1, HB1, ssq_ptr(ws, l, 4), nullptr, nullptr, nullptr, nullptr};
            pg8::gemm_phase(lds, g, S, E); }
        } else { if (PH_EN(8)) {
            pg8::Gemm g{HB1, (const bf16_t*)(wl + WO_G), MTOK, DM, DM}; S.init(MTOK, DM, G, bx);
            ssq_t* nxt = (l + 1 < DEPTH) ? ssq_ptr(ws, l + 1, 0) : ssq_ptr(ws, 0, 1);
            pg8::EpiRes<2> E{HB1, HB0, nxt, ssq_ptr(ws, l, 4), (const bf16_t*)(ws + WS_PP), nullptr, build_rstd_tab(lds, S, ssq_ptr(ws, l, 4))};
            pg8::gemm_phase(lds, g, S, E); }
        }
        if (ph + 1 < ph_hi) { xcd_barrier(xbar); if (PROBE_REP & 8) xcd_barrier(xbar); }
    }
    if (ph == NPHASE - 1 && ph < ph_hi) { if (PH_EN(10)) {
        float* O = a_in.out; const bf16_t* HB0 = (const bf16_t*)(a_in.ws + WS_HB);
        const int tid = opaque_tid(), lane = tid & 63, gw = bx * 8 + (tid >> 6), NGW = G * 8;
        const f32x4* gf = (const f32x4*)a_in.in[I_NFIN] + 2 * lane;
        for (int m = gw; m < MTOK; m += 2 * NGW) {
            const int m2 = (m + NGW < MTOK) ? m + NGW : m;
            const u32x4* hr = (const u32x4*)(HB0 + (size_t)m * DM) + lane; const u32x4* hr2 = (const u32x4*)(HB0 + (size_t)m2 * DM) + lane;
            u32x4 wv[2][2];
#pragma unroll
            for (int j = 0; j < 2; ++j) { wv[0][j] = hr[64 * j]; wv[1][j] = hr2[64 * j]; }
#pragma unroll
            for (int q = 0; q < 2; ++q) { const int mr = q ? m2 : m; f32x4* orow = (f32x4*)(O + (size_t)mr * DM) + 2 * lane; float v[2][8]; float s = 0.f;
#pragma unroll
                for (int j = 0; j < 2; ++j) { const u32x4 w = wv[q][j]; v[j][0] = bflo(w.x); v[j][1] = bfhi(w.x); v[j][2] = bflo(w.y); v[j][3] = bfhi(w.y); v[j][4] = bflo(w.z); v[j][5] = bfhi(w.z); v[j][6] = bflo(w.w); v[j][7] = bfhi(w.w);
#pragma unroll
                    for (int k = 0; k < 8; ++k) s += v[j][k] * v[j][k]; }
                const float rs = rsqrtf(wave_sum(s) * (1.f / DM) + EPS);
                if (q == 0 || m2 != m) {
#pragma unroll
                for (int j = 0; j < 2; ++j) { const f32x4 g0 = gf[128 * j], g1 = gf[128 * j + 1];
                    orow[128 * j] = (f32x4){v[j][0] * rs * g0[0], v[j][1] * rs * g0[1], v[j][2] * rs * g0[2], v[j][3] * rs * g0[3]};
                    orow[128 * j + 1] = (f32x4){v[j][4] * rs * g1[0], v[j][5] * rs * g1[1], v[j][6] * rs * g1[2], v[j][7] * rs * g1[3]}; } } } } }
    }
}

extern "C" void kernel_launch(void* const* d_in, const int* in_sizes, int n_in, void* d_out, int out_size, void* d_ws, size_t ws_size, hipStream_t stream) {
    static int grid = 0;
    if (grid == 0) {
        if (n_in != 24 || out_size != MTOK * DM || ws_size < WS_END) { fprintf(stderr, "kernel_launch: unexpected problem: n_in %d out %d ws %zu\n", n_in, out_size, ws_size); grid = -1; return; }
        int dev = 0, cus = 0, per_cu = 0;
        (void)hipGetDevice(&dev); (void)hipDeviceGetAttribute(&cus, hipDeviceAttributeMultiprocessorCount, dev);
        if (hipFuncSetAttribute((const void*)hymba_fwd, hipFuncAttributeMaxDynamicSharedMemorySize, LDS_BYTES) != hipSuccess) { fprintf(stderr, "kernel_launch: hipFuncSetAttribute failed\n"); grid = -1; return; }
        if (hipOccupancyMaxActiveBlocksPerMultiprocessor(&per_cu, (const void*)hymba_fwd, 512, LDS_BYTES) != hipSuccess || per_cu < 1) { fprintf(stderr, "kernel_launch: occupancy query says %d\n", per_cu); per_cu = 1; }
        (void)hipGetLastError();
        grid = cus * 1;
        if (grid < 128) { fprintf(stderr, "kernel_launch: needs >= 128 CUs (phase D's factor table holds 4 units per workgroup), got %d\n", grid); grid = -1; return; }
        fprintf(stderr, "kernel_launch: cus %d per_cu %d grid %d\n", cus, per_cu, grid);
    }
    if (grid < 0) return;
#if MK_MULTI
    if (hipMemsetAsync((char*)d_ws + WS_CTL, 0, CTL_ZERO_BYTES, stream) != hipSuccess) { fprintf(stderr, "kernel_launch: memset of the barrier words failed\n"); return; }
#endif
    Args a{};
    for (int i = 0; i < 24; ++i) a.in[i] = (const float*)d_in[i];
    a.out = (float*)d_out; a.ws = (unsigned char*)d_ws;
#if MK_MULTI
    for (int ph = 0; ph < NPHASE; ++ph) { a.ph_lo = ph; a.ph_hi = ph + 1; hipLaunchKernelGGL(hymba_fwd, dim3(grid), dim3(512), LDS_BYTES, stream, a); }
#else
    a.ph_lo = 0; a.ph_hi = NPHASE;
    void* args[] = {&a};
    hipError_t e = hipLaunchCooperativeKernel((const void*)hymba_fwd, dim3(grid), dim3(512), args, LDS_BYTES, stream);
    if (e != hipSuccess) fprintf(stderr, "kernel_launch: cooperative launch failed: %s (grid %d)\n", hipGetErrorString(e), grid);
#endif
}
```

```cpp
#include <hip/hip_runtime.h>
#include <hip/hip_cooperative_groups.h>
#include <cstdio>
#include <cstdint>
namespace cg = cooperative_groups;

#ifndef MK_MULTI
#define MK_MULTI 0
#endif

#ifndef PROBE_REP
#define PROBE_REP 0
#endif
#ifndef PH_MASK
#define PH_MASK 0xFFFF
#endif
#define PH_EN(k) (((PH_MASK) >> (k)) & 1)
#define LAS __attribute__((address_space(3)))
#define GAS __attribute__((address_space(1)))
typedef unsigned short bf16_t;
typedef short bf16x8 __attribute__((ext_vector_type(8)));
typedef short bf16x4 __attribute__((ext_vector_type(4)));
typedef float f32x4 __attribute__((ext_vector_type(4)));
typedef float f32x2 __attribute__((ext_vector_type(2)));
typedef unsigned u32x4 __attribute__((ext_vector_type(4)));
typedef unsigned u32x2 __attribute__((ext_vector_type(2)));

constexpr int DM = 1024, BATCH = 8, SEQ = 4096, DEPTH = 4, MTOK = BATCH * SEQ;
constexpr int SSMW = 512, NG = 32, NS = 64, ATTW = 512, KVW = 128, INW = 1280, FFH = 2816, PLE = 256;
constexpr float EPS = 1e-6f;
constexpr float QSCALE = 0.125f * 1.4426950408889634f;
constexpr float LOG2E = 1.4426950408889634f;

constexpr size_t MiB = 1u << 20;
constexpr size_t WS_SSQ = 472 * MiB;
constexpr size_t WS_BMAT = 4 * MiB;
constexpr size_t WS_CMAT = 5 * MiB;
constexpr size_t WS_LAM = 6 * MiB;
constexpr size_t WS_W = 8 * MiB, W_LAYER = 24 * MiB;
constexpr size_t WO_IN = 0, WO_GLU = 2 * MiB + 512 * 1024, WO_OUT = 3 * MiB, WO_FI = 5 * MiB, WO_FO = 16 * MiB, WO_G = 21 * MiB + 512 * 1024, WO_P = 23 * MiB + 512 * 1024;
constexpr size_t WS_HB = 104 * MiB;
constexpr size_t WS_PB = 168 * MiB;
constexpr size_t WS_PP = 232 * MiB;
constexpr size_t WS_OV = 296 * MiB;
constexpr size_t WS_HID = WS_OV;
constexpr size_t WS_UG = WS_OV, WS_Q = WS_OV + 32 * MiB, WS_K = WS_OV + 64 * MiB, WS_V = WS_OV + 72 * MiB, WS_YG = WS_OV + 80 * MiB, WS_MIX = WS_OV + 112 * MiB;
constexpr size_t WS_SSMW = 478 * MiB;
constexpr size_t WS_END = 510 * MiB;
static_assert(WO_P + (size_t)1024 * 256 * 2 <= W_LAYER, "weight map");
static_assert(WS_HID + (size_t)MTOK * FFH * 2 <= WS_SSQ && WS_MIX + (size_t)MTOK * 1024 * 2 <= WS_SSQ, "ws map");

constexpr int LDS_BYTES = 147456;
constexpr int LDS_FAC_OFF = 131072, LDS_BAR_OFF = 147440;
constexpr size_t WS_CTL = 0, CTL_ZERO_BYTES = 16384;
constexpr int NPHASE = 1 + 7 * DEPTH + 1;

__device__ __forceinline__ unsigned cvt_pk_bf16(float lo, float hi) { unsigned r; asm volatile("v_cvt_pk_bf16_f32 %0, %1, %2" : "=v"(r) : "v"(lo), "v"(hi)); return r; }
__device__ __forceinline__ unsigned f2bf(float f) { unsigned u = __builtin_bit_cast(unsigned, f); return (u + 0x7fffu + ((u >> 16) & 1u)) >> 16; }
__device__ __forceinline__ float bflo(unsigned w) { return __builtin_bit_cast(float, w << 16); }
__device__ __forceinline__ float bfhi(unsigned w) { return __builtin_bit_cast(float, w & 0xffff0000u); }
__device__ __forceinline__ float sigm(float x) { return __builtin_amdgcn_rcpf(1.f + __builtin_amdgcn_exp2f(-LOG2E * x)); }
#define LDS_WAIT() asm volatile("s_waitcnt lgkmcnt(0)" ::: "memory")
#ifndef WT_STORES
#define WT_STORES 0
#endif
__device__ __forceinline__ void st16(void* p, u32x4 v) {
#if WT_STORES
    asm volatile("global_store_dwordx4 %0, %1, off sc0 sc1" :: "v"(p), "v"(v) : "memory");
#else
    *(u32x4*)p = v;
#endif
}
#define LBAR() do { asm volatile("s_waitcnt lgkmcnt(0)" ::: "memory"); __builtin_amdgcn_s_barrier(); asm volatile("" ::: "memory"); } while (0)
typedef unsigned long long ssq_t;
__device__ __forceinline__ void ssq_add(ssq_t* p, float v) { atomicAdd(p, (ssq_t)(v * 268435456.f)); }
__device__ __forceinline__ float ssq_get(const ssq_t* p) { return (float)(*p) * (1.f / 268435456.f); }
__device__ __forceinline__ int opaque_tid() { int t = threadIdx.x; asm volatile("" : "+v"(t)); return t; }

namespace pg8 {
constexpr int BM = 256, BK = 64, HALF = 128, HTB = HALF * BK * 2, STAGE_BYTES = 8 * HTB, NXCD = 8, WGM = 4;
__host__ __device__ __forceinline__ int lds_byte(int r, int c) { const int st = (r >> 4) * 2 + (c >> 5), rr = r & 15, cc = c & 31, ob = rr * 64 + cc * 2; return st * 1024 + (ob ^ (((ob >> 9) & 1) << 5)); }
__host__ __device__ __forceinline__ void stage_rc(int b, int& R, int& C) { const int st = b / 1024, sb = b % 1024, swz = sb ^ (((sb >> 9) & 1) << 5); R = (st >> 1) * 16 + swz / 64; C = (st & 1) * 32 + (swz % 64) / 2; }
__host__ __device__ __forceinline__ int perm32(int rho) { const int n = rho >> 4, i = rho & 15; return 8 * (i >> 2) + 4 * n + (i & 3); }

struct Unit { int pm, pn; };
struct Gemm { const bf16_t* A; const bf16_t* Bt; int M, N, K; };

struct StaticOrder {
    int nM, nN, nwg, G, c;
    __host__ __device__ void init(int M, int N, int G_, int c_) { nM = M / BM; nN = N / BM; nwg = nM * nN; G = G_; c = c_; }
    __host__ __device__ bool next(int i, Unit& u) const {
        const long L = (long)i * G + c; if (L >= nwg) return false;
        int wgid = (int)L; { const int q = nwg / NXCD, r = nwg % NXCD, xcd = wgid % NXCD, off = wgid / NXCD; wgid = (xcd < r ? xcd * (q + 1) : r * (q + 1) + (xcd - r) * q) + off; }
        const int nig = WGM * nN, gid = wgid / nig, fm = gid * WGM, gsz = (nM - fm) < WGM ? (nM - fm) : WGM;
        u.pm = fm + ((wgid % nig) % gsz); u.pn = (wgid % nig) / gsz; return true;
    }
};

template <class Epi>
__device__ __forceinline__ void gemm_phase(LAS unsigned char* lds, const Gemm g, const StaticOrder& S, const Epi& E) {
    const int tid = opaque_tid(), wid = __builtin_amdgcn_readfirstlane(tid >> 6), lane = tid & 63, wr = wid >> 2, wc = wid & 3, fr = lane & 15, fq = lane >> 4;
    const int K = g.K, nt = K / BK;
    unsigned voffA, voffB;
    { int R, C; stage_rc(tid * 16, R, C); const int Rb = Epi::PERM ? ((R & ~31) + perm32(R & 31)) : R;
        voffA = (unsigned)(R * K + C) * 2u; voffB = (unsigned)(Rb * K + C) * 2u; }
    const size_t pstep = (size_t)64 * K * 2;
    const size_t kstep = (size_t)(BK * 2);
    const size_t hstep = (size_t)HALF * K * 2;
    const size_t tstep = 2 * hstep;
    const unsigned ldsw = (unsigned)wid * 1024u;
    const int aoff = lds_byte(wr * 64 + fr, fq * 8), boff = lds_byte(wc * 32 + fr, fq * 8);
#define PG8_SA(b, h) (((b) * 2 + (h)) * HTB)
#define PG8_SB(b, h) ((4 + (b) * 2 + (h)) * HTB)
#define PG8_STAGE(bufoff, gbase, voff) do { _Pragma("unroll") for (int _i = 0; _i < 2; ++_i) \
        __builtin_amdgcn_global_load_lds((const unsigned*)((const char*)(gbase) + _i * pstep + (voff)), (LAS unsigned*)(lds + (bufoff) + ldsw + _i * 8192), 16, 0, 0); } while (0)
#define PG8_LDA(dst, b, h) do { _Pragma("unroll") for (int m = 0; m < 4; ++m) _Pragma("unroll") for (int k = 0; k < 2; ++k) dst[m][k] = *(const LAS bf16x8*)(lds + PG8_SA(b, h) + aoff + m * 2048 + k * 1024); } while (0)
#define PG8_LDB(dst, b, h) do { _Pragma("unroll") for (int n = 0; n < 2; ++n) _Pragma("unroll") for (int k = 0; k < 2; ++k) dst[n][k] = *(const LAS bf16x8*)(lds + PG8_SB(b, h) + boff + n * 2048 + k * 1024); } while (0)
#define PG8_MMA(ai, bj, At, Bt) do { __builtin_amdgcn_s_setprio(1); _Pragma("unroll") for (int m = 0; m < 4; ++m) _Pragma("unroll") for (int n = 0; n < 2; ++n) _Pragma("unroll") for (int k = 0; k < 2; ++k) \
        acc[ai][bj][m][n] = __builtin_amdgcn_mfma_f32_16x16x32_bf16(Bt[n][k], At[m][k], acc[ai][bj][m][n], 0, 0, 0); __builtin_amdgcn_s_setprio(0); } while (0)
#define PG8_WAIT_V(n) asm volatile("s_waitcnt vmcnt(" #n ")" ::: "memory")
#define PG8_WAIT_L(n) asm volatile("s_waitcnt lgkmcnt(" #n ")" ::: "memory")
#define PG8_BAR __builtin_amdgcn_s_barrier()
#define PG8_SCHED __builtin_amdgcn_sched_barrier(0)
    Unit cur, nxt; int ui = 0;
    if (!S.next(0, cur)) return;
    f32x4 acc[2][2][4][2];
#pragma unroll
    for (int a = 0; a < 2; ++a)
#pragma unroll
        for (int b = 0; b < 2; ++b)
#pragma unroll
            for (int m = 0; m < 4; ++m)
#pragma unroll
                for (int n = 0; n < 2; ++n) acc[a][b][m][n] = (f32x4){0.f, 0.f, 0.f, 0.f};
    bf16x8 At[4][2], B0[2][2], B1[2][2];
    const char* cA = (const char*)g.A + (size_t)cur.pm * tstep; const char* cB = (const char*)g.Bt + (size_t)cur.pn * tstep;
    PG8_STAGE(PG8_SB(0, 0), cB, voffB); PG8_STAGE(PG8_SB(0, 1), cB + hstep, voffB); PG8_STAGE(PG8_SA(0, 0), cA, voffA); PG8_STAGE(PG8_SA(0, 1), cA + hstep, voffA);
    if (wr == 1) PG8_BAR;
    PG8_WAIT_V(2); PG8_BAR;
    PG8_STAGE(PG8_SB(1, 0), cB + kstep, voffB); PG8_STAGE(PG8_SA(1, 0), cA + kstep, voffA); PG8_STAGE(PG8_SB(1, 1), cB + hstep + kstep, voffB);
    PG8_WAIT_V(6); PG8_BAR;
    for (;;) {
        const bool has_next = S.next(ui + 1, nxt);
        const char* nA = has_next ? (const char*)g.A + (size_t)nxt.pm * tstep : cA; const char* nB = has_next ? (const char*)g.Bt + (size_t)nxt.pn * tstep : cB;
#pragma unroll 1
        for (int t = 0; t < nt; t += 2) {
            const bool last = (t == nt - 2);
            const char* a1 = cA + (size_t)(t + 1) * kstep;
            const char* a2 = last ? nA : cA + (size_t)(t + 2) * kstep; const char* b2 = last ? nB : cB + (size_t)(t + 2) * kstep;
            const char* a3 = a2 + kstep; const char* b3 = b2 + kstep;
            if constexpr (Epi::MID) { if (t == (nt >> 1)) E.mid(acc, ui, wr, wc, fr, fq); }
            PG8_LDB(B0, 0, 0); PG8_LDB(B1, 0, 1); PG8_SCHED; PG8_LDA(At, 0, 0); PG8_STAGE(PG8_SA(1, 1), a1 + hstep, voffA);
            PG8_WAIT_V(8); PG8_WAIT_L(0); PG8_BAR; PG8_MMA(0, 0, At, B0); PG8_MMA(0, 1, At, B1); PG8_BAR; PG8_SCHED;
            PG8_LDA(At, 0, 1); PG8_STAGE(PG8_SB(0, 0), b2, voffB); PG8_STAGE(PG8_SB(0, 1), b2 + hstep, voffB); PG8_STAGE(PG8_SA(0, 0), a2, voffA);
            PG8_WAIT_V(8); PG8_WAIT_L(0); PG8_BAR; PG8_MMA(1, 0, At, B0); PG8_MMA(1, 1, At, B1); PG8_BAR; PG8_SCHED;
            PG8_LDB(B0, 1, 0); PG8_LDB(B1, 1, 1); PG8_SCHED; PG8_LDA(At, 1, 0); PG8_STAGE(PG8_SA(0, 1), a2 + hstep, voffA);
            PG8_WAIT_V(8); PG8_WAIT_L(0); PG8_BAR; PG8_MMA(0, 0, At, B0); PG8_MMA(0, 1, At, B1); PG8_BAR; PG8_SCHED;
            PG8_LDA(At, 1, 1); PG8_STAGE(PG8_SB(1, 0), b3, voffB); PG8_STAGE(PG8_SB(1, 1), b3 + hstep, voffB); PG8_STAGE(PG8_SA(1, 0), a3, voffA);
            PG8_WAIT_V(8); PG8_WAIT_L(0); PG8_BAR; PG8_MMA(1, 0, At, B0); PG8_MMA(1, 1, At, B1); PG8_BAR; PG8_SCHED;
        }
        if (wr == 0) PG8_BAR;
        E(acc, cur, ui, wr, wc, fr, fq);
        if (!has_next) break;
#pragma unroll
        for (int a = 0; a < 2; ++a)
#pragma unroll
            for (int b = 0; b < 2; ++b)
#pragma unroll
                for (int m = 0; m < 4; ++m)
#pragma unroll
                    for (int n = 0; n < 2; ++n) acc[a][b][m][n] = (f32x4){0.f, 0.f, 0.f, 0.f};
        cur = nxt; cA = nA; cB = nB; ++ui;
        if (wr == 1) PG8_BAR;
    }
    PG8_WAIT_V(0);
    PG8_BAR;
#undef PG8_SA
#undef PG8_SB
#undef PG8_STAGE
#undef PG8_LDA
#undef PG8_LDB
#undef PG8_MMA
#undef PG8_WAIT_V
#undef PG8_WAIT_L
#undef PG8_BAR
#undef PG8_SCHED
}

typedef f32x4 Acc[2][2][4][2];

struct EpiInProj {
    static constexpr bool PERM = true, MID = false;
    const ssq_t* ssq; bf16_t *UG, *Q, *K, *V; const LAS float* tab;
    __device__ __forceinline__ void operator()(const Acc& acc, const Unit& u, int ui, int wr, int wc, int fr, int fq) const {
        const int row0 = u.pm * BM + wr * 64 + fr;
#pragma unroll
        for (int ai = 0; ai < 2; ++ai)
#pragma unroll
            for (int m = 0; m < 4; ++m) {
                const int row = row0 + ai * HALF + m * 16;
                const float rs = tab ? tab[ui * 256 + wr * 64 + fr + ai * HALF + m * 16] : rsqrtf(ssq_get(ssq + row) * (1.f / 1024.f) + EPS);
#pragma unroll
                for (int bj = 0; bj < 2; ++bj) {
                    const int c = u.pn * BM + bj * HALF + wc * 32 + 8 * fq;
                    float sc = rs; bf16_t* dst;
                    if (c < 512) dst = UG + ((size_t)(c >> 4) * MTOK + row) * 16 + (c & 15);
                    else if (c < 1024) { dst = Q + (size_t)row * 512 + (c - 512); sc *= QSCALE; }
                    else if (c < 1152) dst = K + (size_t)row * 128 + (c - 1024);
                    else dst = V + (size_t)row * 128 + (c - 1152);
                    const f32x4 v0 = acc[ai][bj][m][0] * sc, v1 = acc[ai][bj][m][1] * sc;
                    u32x4 w; w.x = cvt_pk_bf16(v0[0], v0[1]); w.y = cvt_pk_bf16(v0[2], v0[3]); w.z = cvt_pk_bf16(v1[0], v1[1]); w.w = cvt_pk_bf16(v1[2], v1[3]);
                    st16(dst, w);
                }
            }
    }
};

struct EpiGlu {
    static constexpr bool PERM = true, MID = false;
    const bf16_t* YG; bf16_t* MIX; ssq_t* ssq;
    __device__ __forceinline__ void operator()(const Acc& acc, const Unit& u, int ui, int wr, int wc, int fr, int fq) const {
        const int row0 = u.pm * BM + wr * 64 + fr;
#pragma unroll
        for (int ai = 0; ai < 2; ++ai)
#pragma unroll
            for (int m = 0; m < 4; ++m) {
                const int row = row0 + ai * HALF + m * 16; float part = 0.f;
#pragma unroll
                for (int bj = 0; bj < 2; ++bj) {
                    const int c = u.pn * BM + bj * HALF + wc * 32 + 8 * fq;
                    const u32x4 yw = *(const u32x4*)(YG + (size_t)row * 512 + c);
                    const f32x4 z0 = acc[ai][bj][m][0], z1 = acc[ai][bj][m][1];
                    float o[8];
                    o[0] = bflo(yw.x) * sigm(z0[0]); o[1] = bfhi(yw.x) * sigm(z0[1]); o[2] = bflo(yw.y) * sigm(z0[2]); o[3] = bfhi(yw.y) * sigm(z0[3]);
                    o[4] = bflo(yw.z) * sigm(z1[0]); o[5] = bfhi(yw.z) * sigm(z1[1]); o[6] = bflo(yw.w) * sigm(z1[2]); o[7] = bfhi(yw.w) * sigm(z1[3]);
#pragma unroll
                    for (int j = 0; j < 8; ++j) part += o[j] * o[j];
                    u32x4 w; w.x = cvt_pk_bf16(o[0], o[1]); w.y = cvt_pk_bf16(o[2], o[3]); w.z = cvt_pk_bf16(o[4], o[5]); w.w = cvt_pk_bf16(o[6], o[7]);
                    st16(MIX + (size_t)row * 1024 + c, w);
                }
                part += __shfl_xor(part, 16); part += __shfl_xor(part, 32);
                if (fq == 0) ssq_add(ssq + row, part);
            }
    }
};

struct EpiPlain {
    static constexpr bool PERM = true, MID = false;
    bf16_t* O;
    __device__ __forceinline__ void operator()(const Acc& acc, const Unit& u, int ui, int wr, int wc, int fr, int fq) const {
        const int row0 = u.pm * BM + wr * 64 + fr;
#pragma unroll
        for (int ai = 0; ai < 2; ++ai)
#pragma unroll
            for (int m = 0; m < 4; ++m) {
                const int row = row0 + ai * HALF + m * 16;
#pragma unroll
                for (int bj = 0; bj < 2; ++bj) {
                    const int c = u.pn * BM + bj * HALF + wc * 32 + 8 * fq;
                    const f32x4 v0 = acc[ai][bj][m][0], v1 = acc[ai][bj][m][1];
                    u32x4 w; w.x = cvt_pk_bf16(v0[0], v0[1]); w.y = cvt_pk_bf16(v0[2], v0[3]); w.z = cvt_pk_bf16(v1[0], v1[1]); w.w = cvt_pk_bf16(v1[2], v1[3]);
                    st16(O + (size_t)row * 1024 + c, w);
                }
            }
    }
};

struct EpiFfnIn {
    static constexpr bool PERM = true, MID = false;
    const ssq_t* ssq; bf16_t* HID; const LAS float* tab;
    __device__ __forceinline__ void operator()(const Acc& acc, const Unit& u, int ui, int wr, int wc, int fr, int fq) const {
        const int row0 = u.pm * BM + wr * 64 + fr; const int c = u.pn * HALF + wc * 32 + 8 * fq;
#pragma unroll
        for (int ai = 0; ai < 2; ++ai)
#pragma unroll
            for (int m = 0; m < 4; ++m) {
                const int row = row0 + ai * HALF + m * 16;
                const float rs = tab ? tab[ui * 256 + wr * 64 + fr + ai * HALF + m * 16] : rsqrtf(ssq_get(ssq + row) * (1.f / 1024.f) + EPS);
                const float c1 = -LOG2E * rs, c2 = rs * rs;
                float o[8];
#pragma unroll
                for (int n = 0; n < 2; ++n)
#pragma unroll
                    for (int j = 0; j < 4; j += 2) { const f32x2 g2 = {acc[ai][0][m][n][j], acc[ai][0][m][n][j + 1]}, u2 = {acc[ai][1][m][n][j], acc[ai][1][m][n][j + 1]};
                        const f32x2 ea = g2 * c1; f32x2 dn; dn.x = __builtin_amdgcn_exp2f(ea.x); dn.y = __builtin_amdgcn_exp2f(ea.y); dn = dn + 1.0f;
                        f32x2 rc; rc.x = __builtin_amdgcn_rcpf(dn.x); rc.y = __builtin_amdgcn_rcpf(dn.y);
                        const f32x2 r2 = (g2 * u2) * (rc * c2); o[n * 4 + j] = r2.x; o[n * 4 + j + 1] = r2.y; }
                u32x4 w; w.x = cvt_pk_bf16(o[0], o[1]); w.y = cvt_pk_bf16(o[2], o[3]); w.z = cvt_pk_bf16(o[4], o[5]); w.w = cvt_pk_bf16(o[6], o[7]);
                st16(HID + (size_t)row * FFH + c, w);
            }
    }
};

template <int MODE> struct EpiRes {
    static constexpr bool PERM = true, MID = (MODE == 1);
    const bf16_t* HR; bf16_t* HW; ssq_t* ssq_out; const ssq_t* ssq_a; const bf16_t* PP; const LAS f32x2* fac; const LAS float* tab;
    __device__ __forceinline__ void mid(Acc& acc, int ui, int wr, int wc, int fr, int fq) const {
        const LAS f32x2* T = fac + (ui & 3) * 256 + wr * 64 + fr;
#pragma unroll
        for (int ai = 0; ai < 2; ++ai)
#pragma unroll
            for (int m = 0; m < 4; ++m) {
                const float f = T[ai * HALF + m * 16].x;
#pragma unroll
                for (int bj = 0; bj < 2; ++bj)
#pragma unroll
                    for (int n = 0; n < 2; ++n) acc[ai][bj][m][n] = acc[ai][bj][m][n] * f;
            }
    }
    __device__ __forceinline__ void operator()(const Acc& acc, const Unit& u, int ui, int wr, int wc, int fr, int fq) const {
        const int row0 = u.pm * BM + wr * 64 + fr; const int col0 = u.pn * BM + wc * 32 + 8 * fq;
        constexpr int NB = (MODE == 2) ? 2 : 4;
#pragma unroll
        for (int g0 = 0; g0 < 8; g0 += NB) {
            u32x4 hw[NB][2], pw[(MODE == 2) ? NB : 1][2]; float rs[NB];
#pragma unroll
            for (int gi = 0; gi < NB; ++gi) { const int g = g0 + gi, ai = g >> 2, m = g & 3;
                const int row = row0 + ai * HALF + m * 16; const size_t off = (size_t)row * 1024 + col0;
#pragma unroll
                for (int bj = 0; bj < 2; ++bj) { hw[gi][bj] = *(const u32x4*)(HR + off + bj * HALF); if (MODE == 2) pw[gi][bj] = *(const u32x4*)(PP + off + bj * HALF); }
                rs[gi] = 1.f;
                if (MODE == 1) rs[gi] = fac[(ui & 3) * 256 + wr * 64 + fr + ai * HALF + m * 16].y;
                if (MODE == 2) rs[gi] = tab ? tab[ui * 256 + wr * 64 + fr + ai * HALF + m * 16] : rsqrtf(ssq_get(ssq_a + row) * (1.f / 1024.f) + EPS);
            }
#pragma unroll
            for (int gi = 0; gi < NB; ++gi) { const int g = g0 + gi, ai = g >> 2, m = g & 3;
                const int row = row0 + ai * HALF + m * 16; const size_t off = (size_t)row * 1024 + col0; float part = 0.f;
                const float r = rs[gi];
#pragma unroll
                for (int bj = 0; bj < 2; ++bj) {
                    const size_t o2 = off + bj * HALF;
                    const u32x4 h4 = hw[gi][bj];
                    const f32x4 a0 = acc[ai][bj][m][0], a1 = acc[ai][bj][m][1];
                    float d[8] = {a0[0], a0[1], a0[2], a0[3], a1[0], a1[1], a1[2], a1[3]};
                    if (MODE == 1) {
#pragma unroll
                        for (int j = 0; j < 8; ++j) d[j] *= r;
                    }
                    if (MODE == 2) { const u32x4 p4 = pw[gi][bj];
                        const float pp[8] = {bflo(p4.x), bfhi(p4.x), bflo(p4.y), bfhi(p4.y), bflo(p4.z), bfhi(p4.z), bflo(p4.w), bfhi(p4.w)};
#pragma unroll
                        for (int j = 0; j < 8; ++j) d[j] = sigm(d[j] * r) * pp[j]; }
                    float o[8];
                    o[0] = bflo(h4.x) + d[0]; o[1] = bfhi(h4.x) + d[1]; o[2] = bflo(h4.y) + d[2]; o[3] = bfhi(h4.y) + d[3];
                    o[4] = bflo(h4.z) + d[4]; o[5] = bfhi(h4.z) + d[5]; o[6] = bflo(h4.w) + d[6]; o[7] = bfhi(h4.w) + d[7];
                    u32x4 w; w.x = cvt_pk_bf16(o[0], o[1]); w.y = cvt_pk_bf16(o[2], o[3]); w.z = cvt_pk_bf16(o[4], o[5]); w.w = cvt_pk_bf16(o[6], o[7]);
                    st16(HW + o2, w);
#pragma unroll
                    for (int j = 0; j < 8; ++j) part += o[j] * o[j];
                }
                part += __shfl_xor(part, 16); part += __shfl_xor(part, 32);
                if (fq == 0) ssq_add(ssq_out + row, part);
            }
            asm volatile("" ::: "memory");
        }
    }
};
}

struct Args { const float* in[24]; float* out; unsigned char* ws; int ph_lo, ph_hi; };
enum { I_X = 0, I_P, I_NMIX, I_WIN, I_ARE, I_AIM, I_LDT, I_BRE, I_BIM, I_CRE, I_CIM, I_D, I_WGLU, I_SINK, I_NSSM, I_NATT, I_WOUT, I_NFFN, I_WFI, I_WFO, I_NPLE, I_WG, I_WP, I_NFIN };

__device__ __forceinline__ ssq_t* ssq_ptr(unsigned char* ws, int l, int type) { return (ssq_t*)(ws + WS_SSQ) + ((size_t)l * 6 + type) * MTOK; }

__device__ __forceinline__ void tr_item(const float* W, int K, int N, bf16_t* WT, const float* s0, const float* s1, int ksplit, bool ffn_map, LAS float* scr, int item, int lane) {
    const int nblk = N / 32, kb = item / nblk, nb = item % nblk, k0 = 64 * kb, n0 = 32 * nb;
    float wv[32];
#pragma unroll
    for (int i = 0; i < 32; ++i) { const int kk = 2 * i + (lane >> 5); wv[i] = W[(size_t)(k0 + kk) * N + n0 + (lane & 31)]; }
    if (s0) {
#pragma unroll
        for (int i = 0; i < 32; ++i) { const int k = k0 + 2 * i + (lane >> 5); const float* sp = (k < ksplit) ? (s0 + k) : (s1 + (k - ksplit)); wv[i] *= *sp; } }
#pragma unroll
    for (int i = 0; i < 32; ++i) { const int kk = 2 * i + (lane >> 5); scr[kk * 33 + (lane & 31)] = wv[i]; }
    LDS_WAIT();
    int nr0 = n0;
    if (ffn_map) { if (n0 < FFH) nr0 = 256 * (n0 / 128) + (n0 % 128); else { const int j = n0 - FFH; nr0 = 256 * (j / 128) + 128 + (j % 128); } }
    const int c = lane & 7;
#pragma unroll
    for (int j = 0; j < 4; ++j) { const int n = (lane >> 3) + 8 * j; const LAS float* s = scr + (8 * c) * 33 + n;
        u32x4 o; o.x = cvt_pk_bf16(s[0 * 33], s[1 * 33]); o.y = cvt_pk_bf16(s[2 * 33], s[3 * 33]); o.z = cvt_pk_bf16(s[4 * 33], s[5 * 33]); o.w = cvt_pk_bf16(s[6 * 33], s[7 * 33]);
        *(u32x4*)(WT + (size_t)(nr0 + n) * K + k0 + 8 * c) = o; }
    LDS_WAIT();
}

__device__ __forceinline__ float wave_sum(float v) {
#pragma unroll
    for (int o = 1; o < 64; o <<= 1) v += __shfl_xor(v, o);
    return v;
}

__device__ __forceinline__ void sincos_acc(float x, float& s, float& c) {
    const float nf = rintf(x * 0.6366197723675814f); const int n = (int)nf;
    float r = __builtin_fmaf(nf, -1.5707962513e+00f, x); r = __builtin_fmaf(nf, -7.5497894159e-08f, r); r = __builtin_fmaf(nf, -5.3903029534e-15f, r);
    const float r2 = r * r;
    float sp = __builtin_fmaf(r2, 2.7557319224e-06f, -1.9841269841e-04f); sp = __builtin_fmaf(sp, r2, 8.3333333333e-03f); sp = __builtin_fmaf(sp, r2, -1.6666666667e-01f); sp = __builtin_fmaf(sp * r2, r, r);
    float cp = __builtin_fmaf(r2, -2.7557319224e-07f, 2.4801587302e-05f); cp = __builtin_fmaf(cp, r2, -1.3888888889e-03f); cp = __builtin_fmaf(cp, r2, 4.1666666667e-02f); cp = __builtin_fmaf(cp, r2, -0.5f); cp = __builtin_fmaf(cp, r2, 1.0f);
    const int q = n & 3;
    const float ss = (q & 1) ? cp : sp, cc = (q & 1) ? sp : cp;
    s = (q & 2) ? -ss : ss; c = ((q + 1) & 2) ? -cc : cc;
}

__device__ __forceinline__ void prologue(const Args& a, LAS unsigned char* lds, unsigned char* ws) {
    const int tid = opaque_tid(), lane = tid & 63, wave = tid >> 6;
    const int G = gridDim.x, gw = blockIdx.x * 8 + wave, NGW = G * 8;
    const int gtid = blockIdx.x * 512 + tid, NT = G * 512;
    LAS float* scr = (LAS float*)(lds + wave * 16384);
    constexpr int IT_IN = 16 * 40, IT_GLU = 8 * 16, IT_OUT = 16 * 32, IT_FI = 16 * 176, IT_FO = 44 * 32, IT_G = 16 * 32, IT_P = 4 * 32;
    constexpr int IT_L = IT_IN + IT_GLU + IT_OUT + IT_FI + IT_FO + IT_G + IT_P;
    for (int it = gw; it < IT_L * DEPTH; it += NGW) {
        const int l = it / IT_L; int r = it % IT_L;
        unsigned char* wl = ws + WS_W + (size_t)l * W_LAYER;
        if (r < IT_IN) { tr_item(a.in[I_WIN] + (size_t)l * DM * INW, DM, INW, (bf16_t*)(wl + WO_IN), a.in[I_NMIX] + l * DM, a.in[I_NMIX] + l * DM, DM, false, scr, r, lane); continue; } r -= IT_IN;
        if (r < IT_GLU) { tr_item(a.in[I_WGLU] + (size_t)l * SSMW * SSMW, SSMW, SSMW, (bf16_t*)(wl + WO_GLU), nullptr, nullptr, 0, false, scr, r, lane); continue; } r -= IT_GLU;
        if (r < IT_OUT) { tr_item(a.in[I_WOUT] + (size_t)l * DM * DM, DM, DM, (bf16_t*)(wl + WO_OUT), a.in[I_NSSM] + l * SSMW, a.in[I_NATT] + l * ATTW, SSMW, false, scr, r, lane); continue; } r -= IT_OUT;
        if (r < IT_FI) { tr_item(a.in[I_WFI] + (size_t)l * DM * 2 * FFH, DM, 2 * FFH, (bf16_t*)(wl + WO_FI), a.in[I_NFFN] + l * DM, a.in[I_NFFN] + l * DM, DM, true, scr, r, lane); continue; } r -= IT_FI;
        if (r < IT_FO) { tr_item(a.in[I_WFO] + (size_t)l * FFH * DM, FFH, DM, (bf16_t*)(wl + WO_FO), nullptr, nullptr, 0, false, scr, r, lane); continue; } r -= IT_FO;
        if (r < IT_G) { tr_item(a.in[I_WG] + (size_t)l * DM * DM, DM, DM, (bf16_t*)(wl + WO_G), a.in[I_NPLE] + l * DM, a.in[I_NPLE] + l * DM, DM, false, scr, r, lane); continue; } r -= IT_G;
        tr_item(a.in[I_WP] + (size_t)l * PLE * DM, PLE, DM, (bf16_t*)(wl + WO_P), nullptr, nullptr, 0, false, scr, r, lane);
    }
    {
        ssq_t* ssq0 = ssq_ptr(ws, 0, 0); bf16_t* HB = (bf16_t*)(ws + WS_HB);
        for (int m = gw; m < MTOK; m += 2 * NGW) {
            const int m2 = m + NGW;
            const bool has2 = m2 < MTOK; const int mm2 = has2 ? m2 : m;
            const f32x4* xr = (const f32x4*)(a.in[I_X] + (size_t)m * DM) + lane; const f32x4* xr2 = (const f32x4*)(a.in[I_X] + (size_t)mm2 * DM) + lane;
            f32x4 v[4], v2[4];
#pragma unroll
            for (int j = 0; j < 4; ++j) { v[j] = xr[64 * j]; v2[j] = xr2[64 * j]; }
            u32x2* hb = (u32x2*)(HB + (size_t)m * DM) + lane; u32x2* hb2 = (u32x2*)(HB + (size_t)mm2 * DM) + lane;
            float s = 0.f, s2 = 0.f;
#pragma unroll
            for (int j = 0; j < 4; ++j) { u32x2 w; w.x = cvt_pk_bf16(v[j][0], v[j][1]); w.y = cvt_pk_bf16(v[j][2], v[j][3]); hb[64 * j] = w; s += (v[j][0] * v[j][0] + v[j][1] * v[j][1]) + (v[j][2] * v[j][2] + v[j][3] * v[j][3]);
                u32x2 w2; w2.x = cvt_pk_bf16(v2[j][0], v2[j][1]); w2.y = cvt_pk_bf16(v2[j][2], v2[j][3]); if (has2) hb2[64 * j] = w2; s2 += (v2[j][0] * v2[j][0] + v2[j][1] * v2[j][1]) + (v2[j][2] * v2[j][2] + v2[j][3] * v2[j][3]); }
            s = wave_sum(s); s2 = wave_sum(s2);
            if (lane == 0) { ssq0[m] = (ssq_t)(s * 268435456.f); if (has2) ssq0[m2] = (ssq_t)(s2 * 268435456.f); }
        }
    }
    {
        const f32x4* p4 = (const f32x4*)a.in[I_P]; u32x4* pb = (u32x4*)(ws + WS_PB);
        const int n8 = DEPTH * MTOK * PLE / 8;
#pragma unroll 4
        for (int i = gtid; i < n8; i += NT) { const f32x4 v0 = p4[2 * i], v1 = p4[2 * i + 1]; u32x4 w; w.x = cvt_pk_bf16(v0[0], v0[1]); w.y = cvt_pk_bf16(v0[2], v0[3]); w.z = cvt_pk_bf16(v1[0], v1[1]); w.w = cvt_pk_bf16(v1[2], v1[3]); pb[i] = w; }
    }
    {
        u32x4* z = (u32x4*)(ws + WS_SSQ); const int n4 = DEPTH * 6 * MTOK / 2;
        for (int i = gtid; i < n4; i += NT) if (i >= MTOK / 2) z[i] = (u32x4){0u, 0u, 0u, 0u};
    }
    {
        __syncthreads();
        LAS f32x2* LP = (LAS f32x2*)(lds); LAS f32x2* BB = (LAS f32x2*)(lds + 8704); LAS f32x2* CC = (LAS f32x2*)(lds + 16896); LAS float* KT = (LAS float*)(lds + 25088);
        for (int item = blockIdx.x; item < 2 * DEPTH * NG; item += G) {
            const int lg = item >> 1, part = item & 1, l = lg >> 5;
            if (tid < 64) { const int p = tid;
                const float dt = __expf(a.in[I_LDT][lg]);
                const float ar = a.in[I_ARE][lg * NS + p], ai = a.in[I_AIM][lg * NS + p];
                const float mag = __expf(ar * dt); float sn, cs; sincos_acc(ai * dt, sn, cs);
                const float lr = mag * cs, li = mag * sn;
                const float den = ar * ar + ai * ai, nr = lr - 1.f, ni = li;
                const float fr = (nr * ar + ni * ai) / den, fi = (ni * ar - nr * ai) / den;
                float pr = 1.f, pi = 0.f;
                for (int k = 0; k <= 16; ++k) { LP[k * 64 + p] = (f32x2){pr, pi}; const float tr = pr * lr - pi * li, ti = pr * li + pi * lr; pr = tr; pi = ti; }
                const float* bre = a.in[I_BRE] + ((size_t)lg * NS + p) * 16; const float* bim = a.in[I_BIM] + ((size_t)lg * NS + p) * 16;
#pragma unroll
                for (int h = 0; h < 16; ++h) { const float br = bre[h], bi = bim[h]; BB[p * 16 + h] = (f32x2){fr * br - fi * bi, fr * bi + fi * br}; }
            }
            for (int i = tid; i < 1024; i += 512) CC[i] = (f32x2){a.in[I_CRE][(size_t)lg * 1024 + i], a.in[I_CIM][(size_t)lg * 1024 + i]};
            __syncthreads();
            bf16_t* Mg = (bf16_t*)(ws + WS_SSMW) + (size_t)lg * 131072;
            if (part == 0) {
                for (int i = 0; i < 8; ++i) { const int idx = tid + 512 * i, tau = idx >> 8, h = (idx >> 4) & 15, hp = idx & 15; float acc = 0.f;
                    for (int p = 0; p < 64; ++p) { const f32x2 L = LP[tau * 64 + p], Bp = BB[p * 16 + hp], C = CC[h * 64 + p];
                        const float Pr = L.x * Bp.x - L.y * Bp.y, Pi = L.x * Bp.y + L.y * Bp.x; acc += C.x * Pr - C.y * Pi; }
                    if (tau == 0 && h == hp) acc += a.in[I_D][l * SSMW + (lg & 31) * 16 + h];
                    KT[idx] = acc; }
                __syncthreads();
                for (int i = 0; i < 16; ++i) { const int q = tid + 512 * i, row = q >> 5, trow = row >> 4, h = row & 15, cp = q & 31, sc = cp >> 1, hp0 = (cp & 1) * 8;
                    float v[8];
#pragma unroll
                    for (int j = 0; j < 8; ++j) v[j] = (sc <= trow) ? KT[((trow - sc) << 8) + (h << 4) + hp0 + j] : 0.f;
                    u32x4 w; w.x = cvt_pk_bf16(v[0], v[1]); w.y = cvt_pk_bf16(v[2], v[3]); w.z = cvt_pk_bf16(v[4], v[5]); w.w = cvt_pk_bf16(v[6], v[7]);
                    *(u32x4*)(Mg + (size_t)row * 256 + cp * 8) = w; }
            } else {
                if (tid < 64) ((f32x2*)(ws + WS_LAM))[lg * NS + tid] = LP[16 * 64 + tid];
                for (int i = 0; i < 8; ++i) { const int q = tid + 512 * i, row = q >> 4, trow = row >> 4, h = row & 15, p0 = (q & 15) * 4;
                    unsigned wv[4];
#pragma unroll
                    for (int j = 0; j < 4; ++j) { const f32x2 L = LP[(trow + 1) * 64 + p0 + j], C = CC[h * 64 + p0 + j]; wv[j] = cvt_pk_bf16(C.x * L.x - C.y * L.y, -(C.x * L.y + C.y * L.x)); }
                    *(u32x4*)(Mg + 65536 + (size_t)row * 128 + p0 * 2) = (u32x4){wv[0], wv[1], wv[2], wv[3]}; }
                for (int i = 0; i < 8; ++i) { const int q = tid + 512 * i, n = q >> 5, cp = q & 31, sc = cp >> 1, hp0 = (cp & 1) * 8, p = n >> 1, im = n & 1;
                    const f32x2 L = LP[(15 - sc) * 64 + p]; float v[8];
#pragma unroll
                    for (int j = 0; j < 8; ++j) { const f32x2 Bp = BB[p * 16 + hp0 + j]; v[j] = im ? (L.x * Bp.y + L.y * Bp.x) : (L.x * Bp.x - L.y * Bp.y); }
                    u32x4 w; w.x = cvt_pk_bf16(v[0], v[1]); w.y = cvt_pk_bf16(v[2], v[3]); w.z = cvt_pk_bf16(v[4], v[5]); w.w = cvt_pk_bf16(v[6], v[7]);
                    *(u32x4*)(Mg + 98304 + (size_t)n * 256 + cp * 8) = w; }
            }
            __syncthreads();
        }
    }
}

constexpr int SS_STRIDE = 528;
constexpr int SS_UL = 0, SS_SL = 128 * SS_STRIDE;
static_assert(2 * 128 * SS_STRIDE <= LDS_BAR_OFF, "S5 LDS map");
__device__ __forceinline__ void ssm_item(LAS unsigned char* lds, int b, int g, int l, const Args& a, unsigned char* ws) {
    const int tid = opaque_tid(), lane = tid & 63, w = __builtin_amdgcn_readfirstlane(tid >> 6), fr = lane & 15, fq = lane >> 4;
    const int lg = l * NG + g;
    const bf16_t* U = (const bf16_t*)(ws + WS_UG) + ((size_t)g * MTOK + (size_t)b * SEQ) * 16;
    const bf16_t* Mg = (const bf16_t*)(ws + WS_SSMW) + (size_t)lg * 131072; const bf16_t* Rg = Mg + 65536; const bf16_t* W16 = Mg + 98304;
    bf16_t* YG = (bf16_t*)(ws + WS_YG) + (size_t)b * SEQ * 512 + g * 16;
    const int nt0 = w, nt1 = 15 - w;
    const f32x2 L16 = ((const f32x2*)(ws + WS_LAM))[lg * NS + lane];
    const f32x2 lrr = {L16.x, L16.x}, lii = {-L16.y, L16.y};
    f32x2 x = {0.f, 0.f};
    bf16x8 bfr[8], rfr[4][2];
#pragma unroll
    for (int ks = 0; ks < 8; ++ks) bfr[ks] = *(const bf16x8*)(W16 + (size_t)(16 * w + fr) * 256 + ks * 32 + 8 * fq);
#pragma unroll
    for (int ks = 0; ks < 4; ++ks) { rfr[ks][0] = *(const bf16x8*)(Rg + (size_t)(16 * nt0 + fr) * 128 + ks * 32 + 8 * fq); rfr[ks][1] = *(const bf16x8*)(Rg + (size_t)(16 * nt1 + fr) * 128 + ks * 32 + 8 * fq); }
#pragma unroll 1
    for (int hf = 0; hf < 2; ++hf) {
        const int cb = 128 * hf;
#pragma unroll
        for (int i = 0; i < 8; ++i) { const int pi = tid + 512 * i, row = pi >> 5, cp = pi & 31;
            const u32x4 v = *(const u32x4*)(U + (size_t)(cb + row) * 256 + cp * 8);
            *(LAS u32x4*)(lds + SS_UL + row * SS_STRIDE + cp * 16) = v; }
        LBAR();
        {
#pragma unroll
            for (int m = 0; m < 8; ++m) {
                f32x4 acc = (f32x4){0.f, 0.f, 0.f, 0.f};
#pragma unroll
                for (int ks = 0; ks < 8; ++ks) { const bf16x8 af = *(const LAS bf16x8*)(lds + SS_UL + (16 * m + fr) * SS_STRIDE + ks * 64 + fq * 16);
                    acc = __builtin_amdgcn_mfma_f32_16x16x32_bf16(af, bfr[ks], acc, 0, 0, 0); }
#pragma unroll
                for (int r = 0; r < 4; ++r) *(LAS float*)(lds + SS_SL + (16 * m + 4 * fq + r) * SS_STRIDE + (16 * w + fr) * 4) = acc[r];
            }
        }
        LBAR();
        if (w == 0) {
            LAS unsigned char* srow = lds + SS_SL + lane * 8; LAS unsigned char* xrow = lds + SS_SL + lane * 4;
            f32x2 sv[8], svn[8];
#pragma unroll
            for (int j = 0; j < 8; ++j) sv[j] = *(const LAS f32x2*)(srow + j * SS_STRIDE);
#pragma unroll 1
            for (int c = 0; c < 128; c += 8) {
                const int cn = (c + 8 < 128) ? c + 8 : c;
#pragma unroll
                for (int j = 0; j < 8; ++j) svn[j] = *(const LAS f32x2*)(srow + (cn + j) * SS_STRIDE);
                asm volatile("" ::: "memory");
#pragma unroll
                for (int j = 0; j < 8; ++j) {
                    *(LAS unsigned*)(xrow + (c + j) * SS_STRIDE) = cvt_pk_bf16(x.x, x.y);
                    const f32x2 xs = {x.y, x.x};
                    x = lrr * x + (lii * xs + sv[j]);
                }
                asm volatile("" ::: "memory");
#pragma unroll
                for (int j = 0; j < 8; ++j) sv[j] = svn[j];
            }
        }
        LBAR();
        {
            f32x4 acc[8][2];
#pragma unroll
            for (int m = 0; m < 8; ++m) { acc[m][0] = (f32x4){0.f, 0.f, 0.f, 0.f}; acc[m][1] = (f32x4){0.f, 0.f, 0.f, 0.f}; }
#pragma unroll
            for (int ks = 0; ks < 4; ++ks) {
                const bf16x8 b0 = rfr[ks][0], b1 = rfr[ks][1];
#pragma unroll
                for (int m = 0; m < 8; ++m) { const bf16x8 af = *(const LAS bf16x8*)(lds + SS_SL + (16 * m + fr) * SS_STRIDE + ks * 64 + fq * 16);
                    acc[m][0] = __builtin_amdgcn_mfma_f32_16x16x32_bf16(af, b0, acc[m][0], 0, 0, 0); acc[m][1] = __builtin_amdgcn_mfma_f32_16x16x32_bf16(af, b1, acc[m][1], 0, 0, 0); }
            }
#pragma unroll
            for (int ks = 0; ks < 8; ++ks) {
                if (2 * ks <= nt1) {
                    const bool use0 = (2 * ks <= nt0);
                    const bf16x8 b1 = *(const bf16x8*)(Mg + (size_t)(16 * nt1 + fr) * 256 + ks * 32 + 8 * fq);
                    const bf16x8 b0 = *(const bf16x8*)(Mg + (size_t)(16 * nt0 + fr) * 256 + ks * 32 + 8 * fq);
#pragma unroll
                    for (int m = 0; m < 8; ++m) { const bf16x8 af = *(const LAS bf16x8*)(lds + SS_UL + (16 * m + fr) * SS_STRIDE + ks * 64 + fq * 16);
                        acc[m][1] = __builtin_amdgcn_mfma_f32_16x16x32_bf16(af, b1, acc[m][1], 0, 0, 0);
                        if (use0) acc[m][0] = __builtin_amdgcn_mfma_f32_16x16x32_bf16(af, b0, acc[m][0], 0, 0, 0); }
                }
            }
#pragma unroll
            for (int m = 0; m < 8; ++m)
#pragma unroll
                for (int j = 0; j < 2; ++j)
#pragma unroll
                    for (int r = 0; r < 4; ++r) { const int c = cb + 16 * m + 4 * fq + r, t = j ? nt1 : nt0;
                        const float v = acc[m][j][r];
                        const float o = v * sigm(1.5957691216f * (v + 0.044715f * v * v * v));
                        YG[(size_t)(16 * c + t) * 512 + fr] = (bf16_t)(cvt_pk_bf16(o, 0.f) & 0xffffu); }
        }
        LBAR();
    }
    __syncthreads();
}

constexpr int ATT_KS = 0, ATT_K_STRIDE = 272;
constexpr int ATT_VT = 256 * 272, ATT_V_STRIDE = 528;
static_assert(ATT_VT + 128 * ATT_V_STRIDE <= LDS_BYTES, "attention LDS");
__device__ __forceinline__ void attn_item(LAS unsigned char* lds, int b, int nb, int l, const Args& a, unsigned char* ws, int ssq_type = 2) {
    const int tid = opaque_tid(), lane = tid & 63, w = __builtin_amdgcn_readfirstlane(tid >> 6), fr = lane & 15, fq = lane >> 4;
    const bf16_t* Qg = (const bf16_t*)(ws + WS_Q); const bf16_t* Kg = (const bf16_t*)(ws + WS_K); const bf16_t* Vg = (const bf16_t*)(ws + WS_V);
    bf16_t* MIX = (bf16_t*)(ws + WS_MIX); ssq_t* ssq_att = ssq_ptr(ws, l, ssq_type);
    const int row0 = b * SEQ + nb * 128;
    const int krow0 = row0 - 128;
#pragma unroll
    for (int i = 0; i < 8; ++i) { const int pi = tid + i * 512, r = pi >> 4, cp = pi & 15;
        const bool ok = (nb > 0 || r >= 128);
        u32x4 v = *(const u32x4*)(Kg + (size_t)(ok ? krow0 + r : row0) * 128 + cp * 8);
        if (!ok) v = (u32x4){0u, 0u, 0u, 0u};
        *(LAS u32x4*)(lds + ATT_KS + r * ATT_K_STRIDE + cp * 16) = v; }
#pragma unroll
    for (int i = 0; i < 8; ++i) { const int pi = tid + i * 512, r = pi & 255, cp = pi >> 8;
        const bool ok = (nb > 0 || r >= 128);
        u32x4 v = *(const u32x4*)(Vg + (size_t)(ok ? krow0 + r : row0) * 128 + cp * 8);
        if (!ok) v = (u32x4){0u, 0u, 0u, 0u};
        LAS unsigned char* vb = lds + ATT_VT + (cp * 8) * ATT_V_STRIDE + r * 2;
        *(LAS bf16_t*)(vb + 0 * ATT_V_STRIDE) = (bf16_t)(v.x & 0xffffu); *(LAS bf16_t*)(vb + 1 * ATT_V_STRIDE) = (bf16_t)(v.x >> 16);
        *(LAS bf16_t*)(vb + 2 * ATT_V_STRIDE) = (bf16_t)(v.y & 0xffffu); *(LAS bf16_t*)(vb + 3 * ATT_V_STRIDE) = (bf16_t)(v.y >> 16);
        *(LAS bf16_t*)(vb + 4 * ATT_V_STRIDE) = (bf16_t)(v.z & 0xffffu); *(LAS bf16_t*)(vb + 5 * ATT_V_STRIDE) = (bf16_t)(v.z >> 16);
        *(LAS bf16_t*)(vb + 6 * ATT_V_STRIDE) = (bf16_t)(v.w & 0xffffu); *(LAS bf16_t*)(vb + 7 * ATT_V_STRIDE) = (bf16_t)(v.w >> 16); }
    __syncthreads();
    const int h = w, kvh = w >> 2;
    const float sink2 = a.in[I_SINK][l * 8 + h] * LOG2E;
    const float NEG = -__builtin_inff();
    bf16x8 qn0 = *(const bf16x8*)(Qg + (size_t)(row0 + fr) * 512 + h * 64 + 8 * fq), qn1 = *(const bf16x8*)(Qg + (size_t)(row0 + fr) * 512 + h * 64 + 32 + 8 * fq);
    for (int qt = 0; qt < 8; ++qt) {
        const bf16x8 q0 = qn0, q1 = qn1;
        if (qt < 7) { qn0 = *(const bf16x8*)(Qg + (size_t)(row0 + (qt + 1) * 16 + fr) * 512 + h * 64 + 8 * fq); qn1 = *(const bf16x8*)(Qg + (size_t)(row0 + (qt + 1) * 16 + fr) * 512 + h * 64 + 32 + 8 * fq); }
        f32x4 s[9];
#pragma unroll
        for (int i = 0; i < 9; ++i) {
            const LAS unsigned char* kp = lds + ATT_KS + (16 * (qt + i) + fr) * ATT_K_STRIDE + kvh * 128 + fq * 16;
            const bf16x8 k0 = *(const LAS bf16x8*)kp, k1 = *(const LAS bf16x8*)(kp + 64);
            f32x4 d = __builtin_amdgcn_mfma_f32_16x16x32_bf16(k0, q0, (f32x4){0.f, 0.f, 0.f, 0.f}, 0, 0, 0);
            s[i] = __builtin_amdgcn_mfma_f32_16x16x32_bf16(k1, q1, d, 0, 0, 0);
        }
#pragma unroll
        for (int r = 0; r < 4; ++r) { if (!(4 * fq + r > fr)) s[0][r] = NEG; if (!(4 * fq + r <= fr)) s[8][r] = NEG; }
        if (nb == 0) {
#pragma unroll
            for (int i = 0; i < 8; ++i) if (i < 8 - qt) s[i] = (f32x4){NEG, NEG, NEG, NEG};
        }
        float mx = sink2;
#pragma unroll
        for (int i = 0; i < 9; ++i) mx = fmaxf(mx, fmaxf(fmaxf(s[i][0], s[i][1]), fmaxf(s[i][2], s[i][3])));
        mx = fmaxf(mx, __shfl_xor(mx, 16)); mx = fmaxf(mx, __shfl_xor(mx, 32));
        float sum = 0.f;
#pragma unroll
        for (int i = 0; i < 9; ++i)
#pragma unroll
            for (int r = 0; r < 4; ++r) { const float e = __builtin_amdgcn_exp2f(s[i][r] - mx); s[i][r] = e; sum += e; }
        sum += __shfl_xor(sum, 16); sum += __shfl_xor(sum, 32);
        sum += __builtin_amdgcn_exp2f(sink2 - mx);
        const float inv = __builtin_amdgcn_rcpf(sum);
        f32x4 o[4];
#pragma unroll
        for (int dt = 0; dt < 4; ++dt) o[dt] = (f32x4){0.f, 0.f, 0.f, 0.f};
#pragma unroll
        for (int i = 0; i < 8; i += 2) {
            u32x4 pw; pw.x = cvt_pk_bf16(s[i][0], s[i][1]); pw.y = cvt_pk_bf16(s[i][2], s[i][3]); pw.z = cvt_pk_bf16(s[i + 1][0], s[i + 1][1]); pw.w = cvt_pk_bf16(s[i + 1][2], s[i + 1][3]);
            const bf16x8 pb = __builtin_bit_cast(bf16x8, pw);
#pragma unroll
            for (int dt = 0; dt < 4; ++dt) {
                const LAS unsigned char* vp = lds + ATT_VT + (kvh * 64 + dt * 16 + fr) * ATT_V_STRIDE + (16 * (qt + i) + 4 * fq) * 2;
                const u32x2 va = *(const LAS u32x2*)vp, vb = *(const LAS u32x2*)(vp + 32);
                u32x4 vw; vw.x = va.x; vw.y = va.y; vw.z = vb.x; vw.w = vb.y;
                o[dt] = __builtin_amdgcn_mfma_f32_16x16x32_bf16(__builtin_bit_cast(bf16x8, vw), pb, o[dt], 0, 0, 0);
            }
        }
        {
            u32x2 pw; pw.x = cvt_pk_bf16(s[8][0], s[8][1]); pw.y = cvt_pk_bf16(s[8][2], s[8][3]);
            const bf16x4 pb = __builtin_bit_cast(bf16x4, pw);
#pragma unroll
            for (int dt = 0; dt < 4; ++dt) {
                const LAS unsigned char* vp = lds + ATT_VT + (kvh * 64 + dt * 16 + fr) * ATT_V_STRIDE + (16 * (qt + 8) + 4 * fq) * 2;
                const u32x2 va = *(const LAS u32x2*)vp;
                o[dt] = __builtin_amdgcn_mfma_f32_16x16x16bf16_1k(__builtin_bit_cast(bf16x4, va), pb, o[dt], 0, 0, 0);
            }
        }
        const int row = row0 + qt * 16 + fr; float part = 0.f;
#pragma unroll
        for (int dt = 0; dt < 4; ++dt) { const f32x4 v = o[dt] * inv; part += (v[0] * v[0] + v[1] * v[1]) + (v[2] * v[2] + v[3] * v[3]);
            u32x2 wv; wv.x = cvt_pk_bf16(v[0], v[1]); wv.y = cvt_pk_bf16(v[2], v[3]);
            *(u32x2*)(MIX + (size_t)row * 1024 + 512 + h * 64 + dt * 16 + 4 * fq) = wv; }
        part += __shfl_xor(part, 16); part += __shfl_xor(part, 32);
        if (fq == 0) ssq_add(ssq_att + row, part);
    }
    __syncthreads();
}

#define XB_TMO      128
#define XB_XCNT(j)  (256  + 64 * (j))
#define XB_XSUB(j)  (1280 + 64 * (j))
#define XB_XGEN(j)  (2304 + 64 * (j))
#define XB_TOP      3328
#define XB_TOPGEN   3392
#define XCD_BAR_WORDS 3456
#define XB_SPIN_CAP (1u << 20)
__device__ __forceinline__ unsigned xb_ld(unsigned* p)              { return __hip_atomic_load(p, __ATOMIC_RELAXED, __HIP_MEMORY_SCOPE_AGENT); }
__device__ __forceinline__ unsigned xb_add(unsigned* p, unsigned v) { return __hip_atomic_fetch_add(p, v, __ATOMIC_RELAXED, __HIP_MEMORY_SCOPE_AGENT); }
__device__ __forceinline__ unsigned xb_xcc_id() { return (unsigned)__builtin_amdgcn_s_getreg((3 << 11) | 20) & 0xFu; }
#define XB_SPIN(cond, bar) do { unsigned _sp = 0; while (cond) { __builtin_amdgcn_s_sleep(1); \
    if ((++_sp & 255u) == 0u) { if (xb_ld(&(bar)[XB_TMO])) break; if (_sp > XB_SPIN_CAP) { atomicAdd(&(bar)[XB_TMO], 1u); break; } } } } while (0)
struct XcdBarrier { unsigned* bar; unsigned x; volatile LAS unsigned* st; };
__device__ __forceinline__ XcdBarrier xcd_barrier_post(unsigned* bar, volatile LAS unsigned* st) {
    XcdBarrier b; b.bar = bar; b.x = xb_xcc_id(); b.st = st;
    if (threadIdx.x == 0) (void)xb_add(&bar[XB_XCNT(b.x)], 1u);
    return b;
}
__device__ __forceinline__ void xcd_barrier_complete(unsigned* bar, unsigned x, unsigned& nloc, unsigned& nx) {
    const unsigned G = gridDim.x * gridDim.y * gridDim.z;
    unsigned sum, cnt, mine, sp = 0u;
    for (;;) {
        sum = 0u; cnt = 0u; mine = 0u;
#pragma unroll
        for (unsigned j = 0; j < 16; ++j) { const unsigned c = xb_ld(&bar[XB_XCNT(j)]); sum += c; cnt += (c > 0u) ? 1u : 0u; mine = (j == x) ? c : mine; }
        if (sum == G) break;
        __builtin_amdgcn_s_sleep(1);
        if ((++sp & 255u) == 0u) { if (xb_ld(&bar[XB_TMO])) break; if (sp > XB_SPIN_CAP) { atomicAdd(&bar[XB_TMO], 1u); break; } }
    }
    nloc = mine > 0u ? mine : 1u; nx = cnt > 0u ? cnt : 1u;
}
__device__ __forceinline__ void xcd_barrier(const XcdBarrier& b) {
    asm volatile("s_waitcnt vmcnt(0)" ::: "memory");
    __syncthreads();
    if (threadIdx.x == 0) {
        unsigned* bar = b.bar;
        __builtin_amdgcn_s_waitcnt(0);
        unsigned nloc = b.st[0], nx = b.st[1];
        if (nloc == 0u) { xcd_barrier_complete(bar, b.x, nloc, nx); b.st[0] = nloc; b.st[1] = nx; }
        const unsigned old = xb_add(&bar[XB_XSUB(b.x)], 1u);
        const unsigned gen = old / nloc;
        if (old + 1u == (gen + 1u) * nloc) {
            __builtin_amdgcn_fence(__ATOMIC_RELEASE, "agent");
            asm volatile("s_waitcnt vmcnt(0)" ::: "memory");
            const unsigned og = xb_add(&bar[XB_TOP], 1u);
            const unsigned tg = og / nx;
            if (og + 1u == (tg + 1u) * nx) xb_add(&bar[XB_TOPGEN], 1u);
            else XB_SPIN(xb_ld(&bar[XB_TOPGEN]) == tg, bar);
            __builtin_amdgcn_fence(__ATOMIC_ACQUIRE, "agent");
            xb_add(&bar[XB_XGEN(b.x)], 1u);
            asm volatile("s_waitcnt vmcnt(0)" ::: "memory");
        } else {
            XB_SPIN(xb_ld(&bar[XB_XGEN(b.x)]) == gen, bar);
            __builtin_amdgcn_fence(__ATOMIC_ACQUIRE, "agent");
            asm volatile("s_waitcnt vmcnt(0)" ::: "memory");
        }
    }
    __syncthreads();
}

__device__ __forceinline__ const LAS float* build_rstd_tab(LAS unsigned char* lds, const pg8::StaticOrder& S, const ssq_t* ssq) {
    pg8::Unit uu; if (S.next(15, uu)) return nullptr;
    LAS float* tab = (LAS float*)(lds + LDS_FAC_OFF);
    const int t = opaque_tid();
    for (int i = t >> 8; S.next(i, uu); i += 2) tab[i * 256 + (t & 255)] = rsqrtf(ssq_get(ssq + uu.pm * 256 + (t & 255)) * (1.f / 1024.f) + EPS);
    __syncthreads();
    return tab;
}

__global__ void __launch_bounds__(512, 2) hymba_fwd(Args a_in) {
    extern __shared__ __attribute__((aligned(16))) unsigned char lds_raw[];
    LAS unsigned char* lds = (LAS unsigned char*)lds_raw;
    const int G = gridDim.x, bx = blockIdx.x;
    int ph = a_in.ph_lo; const int ph_hi = a_in.ph_hi;
    volatile LAS unsigned* bst = (volatile LAS unsigned*)(lds + LDS_BAR_OFF);
    if (threadIdx.x < 2) bst[threadIdx.x] = 0u;
    __syncthreads();
#if MK_MULTI
    const XcdBarrier xbar = xcd_barrier_post((unsigned*)(a_in.ws + WS_CTL), bst);
#endif
    if (ph == 0) {
#if !MK_MULTI
        if (bx == 0) { unsigned* bw = (unsigned*)(a_in.ws + WS_CTL); for (int i = threadIdx.x; i < XCD_BAR_WORDS; i += 512) bw[i] = 0u; }
#endif
        if (PH_EN(9)) for (int rep = 0; rep < 1 + ((PROBE_REP >> 2) & 1); ++rep) { prologue(a_in, lds, a_in.ws); __syncthreads(); }
        __syncthreads(); ++ph;
        if (ph < ph_hi) cg::this_grid().sync();
    }
#if !MK_MULTI
    const XcdBarrier xbar = xcd_barrier_post((unsigned*)(a_in.ws + WS_CTL), bst);
#endif
    for (; ph < ph_hi && ph < NPHASE - 1; ++ph) {
        const Args& a = a_in;
        size_t zoff = 0; asm volatile("" : "+s"(zoff));
        unsigned char* ws = a.ws + zoff;
        bf16_t* HB1 = (bf16_t*)a.out + zoff; bf16_t* HB0 = (bf16_t*)(ws + WS_HB);
        const int l = (ph - 1) / 7, j = (ph - 1) % 7;
        unsigned char* wl = ws + WS_W + (size_t)l * W_LAYER;
        pg8::StaticOrder S;
        if (j == 0) { if (PH_EN(0)) {
            pg8::Gemm g{HB0, (const bf16_t*)(wl + WO_IN), MTOK, INW, DM}; S.init(MTOK, INW, G, bx);
            pg8::EpiInProj E{ssq_ptr(ws, l, 0), (bf16_t*)(ws + WS_UG), (bf16_t*)(ws + WS_Q), (bf16_t*)(ws + WS_K), (bf16_t*)(ws + WS_V), build_rstd_tab(lds, S, ssq_ptr(ws, l, 0))};
            pg8::gemm_phase(lds, g, S, E);
            if (PH_EN(4) && G == 256) { pg8::Gemm g2{(const bf16_t*)(ws + WS_PB) + (size_t)l * MTOK * PLE, (const bf16_t*)(wl + WO_P), MTOK, DM, PLE};
              pg8::StaticOrder S2; S2.init(MTOK, DM, 128, bx >= 128 ? bx - 128 : (1 << 20));
              pg8::EpiPlain E2{(bf16_t*)(ws + WS_PP)};
              pg8::gemm_phase(lds, g2, S2, E2); } }
        } else if (j == 1) {
            if (PH_EN(1)) for (int rep = 0; rep < 1 + (PROBE_REP & 1); ++rep) for (int it = bx; it < BATCH * NG; it += G) ssm_item(lds, it >> 5, it & 31, l, a, ws);
            if (PH_EN(2)) for (int rep = 0; rep < 1 + ((PROBE_REP >> 1) & 1); ++rep) for (int it = bx; it < BATCH * (SEQ / 128); it += G) attn_item(lds, it >> 5, it & 31, l, a, ws, rep ? 5 : 2);
        } else if (j == 2) {
            if (PH_EN(3)) { pg8::Gemm g{(const bf16_t*)(ws + WS_YG), (const bf16_t*)(wl + WO_GLU), MTOK, SSMW, SSMW}; S.init(MTOK, SSMW, G, bx);
              pg8::EpiGlu E{(const bf16_t*)(ws + WS_YG), (bf16_t*)(ws + WS_MIX), ssq_ptr(ws, l, 1)};
              pg8::gemm_phase(lds, g, S, E); }
            if (PH_EN(4) && G != 256) { pg8::Gemm g{(const bf16_t*)(ws + WS_PB) + (size_t)l * MTOK * PLE, (const bf16_t*)(wl + WO_P), MTOK, DM, PLE}; S.init(MTOK, DM, G, bx);
              pg8::EpiPlain E{(bf16_t*)(ws + WS_PP)};
              pg8::gemm_phase(lds, g, S, E); }
        } else if (j == 3) { if (PH_EN(5)) {
            pg8::Gemm g{(const bf16_t*)(ws + WS_MIX), (const bf16_t*)(wl + WO_OUT), MTOK, DM, DM}; S.init(MTOK, DM, G, bx);
            LAS f32x2* fac = (LAS f32x2*)(lds + LDS_FAC_OFF);
            { const int t2 = opaque_tid(); const ssq_t* sa = ssq_ptr(ws, l, 1); const ssq_t* sb = ssq_ptr(ws, l, 2); pg8::Unit uu;
              for (int i = 0; i < 4 && S.next(i, uu); ++i) if (t2 < 256) { const int row = uu.pm * 256 + t2;
                  const float rs_s = rsqrtf(ssq_get(sa + row) * (1.f / 512.f) + EPS), rs_a = rsqrtf(ssq_get(sb + row) * (1.f / 512.f) + EPS); fac[i * 256 + t2] = (f32x2){rs_s / rs_a, rs_a}; }
              __syncthreads(); }
            pg8::EpiRes<1> E{HB0, HB1, ssq_ptr(ws, l, 3), nullptr, nullptr, fac, nullptr};
            pg8::gemm_phase(lds, g, S, E); }
        } else if (j == 4) { if (PH_EN(6)) {
            pg8::Gemm g{HB1, (const bf16_t*)(wl + WO_FI), MTOK, 2 * FFH, DM}; S.init(MTOK, 2 * FFH, G, bx);
            pg8::EpiFfnIn E{ssq_ptr(ws, l, 3), (bf16_t*)(ws + WS_HID), build_rstd_tab(lds, S, ssq_ptr(ws, l, 3))};
            for (int rep = 0; rep < 1 + ((PROBE_REP >> 4) & 1); ++rep) pg8::gemm_phase(lds, g, S, E); }
        } else if (j == 5) { if (PH_EN(7)) {
            pg8::Gemm g{(const bf16_t*)(ws + WS_HID), (const bf16_t*)(wl + WO_FO), MTOK, DM, FFH}; S.init(MTOK, DM, G, bx);
            pg8::EpiRes<0> E{HB1, HB1, ssq_ptr(ws, l, 4), nullptr, nullptr, nullptr, nullptr};
            pg8::gemm_phase(lds, g, S, E); }
        } else { if (PH_EN(8)) {
            pg8::Gemm g{HB1, (const bf16_t*)(wl + WO_G), MTOK, DM, DM}; S.init(MTOK, DM, G, bx);
            ssq_t* nxt = (l + 1 < DEPTH) ? ssq_ptr(ws, l + 1, 0) : ssq_ptr(ws, 0, 1);
            pg8::EpiRes<2> E{HB1, HB0, nxt, ssq_ptr(ws, l, 4), (const bf16_t*)(ws + WS_PP), nullptr, build_rstd_tab(lds, S, ssq_ptr(ws, l, 4))};
            pg8::gemm_phase(lds, g, S, E); }
        }
        if (ph + 1 < ph_hi) { xcd_barrier(xbar); if (PROBE_REP & 8) xcd_barrier(xbar); }
    }
    if (ph == NPHASE - 1 && ph < ph_hi) { if (PH_EN(10)) {
        float* O = a_in.out; const bf16_t* HB0 = (const bf16_t*)(a_in.ws + WS_HB);
        const int tid = opaque_tid(), lane = tid & 63, gw = bx * 8 + (tid >> 6), NGW = G * 8;
        const f32x4* gf = (const f32x4*)a_in.in[I_NFIN] + 2 * lane;
        for (int m = gw; m < MTOK; m += 2 * NGW) {
            const int m2 = (m + NGW < MTOK) ? m + NGW : m;
            const u32x4* hr = (const u32x4*)(HB0 + (size_t)m * DM) + lane; const u32x4* hr2 = (const u32x4*)(HB0 + (size_t)m2 * DM) + lane;
            u32x4 wv[2][2];
#pragma unroll
            for (int j = 0; j < 2; ++j) { wv[0][j] = hr[64 * j]; wv[1][j] = hr2[64 * j]; }
#pragma unroll
            for (int q = 0; q < 2; ++q) { const int mr = q ? m2 : m; f32x4* orow = (f32x4*)(O + (size_t)mr * DM) + 2 * lane; float v[2][8]; float s = 0.f;
#pragma unroll
                for (int j = 0; j < 2; ++j) { const u32x4 w = wv[q][j]; v[j][0] = bflo(w.x); v[j][1] = bfhi(w.x); v[j][2] = bflo(w.y); v[j][3] = bfhi(w.y); v[j][4] = bflo(w.z); v[j][5] = bfhi(w.z); v[j][6] = bflo(w.w); v[j][7] = bfhi(w.w);
#pragma unroll
                    for (int k = 0; k < 8; ++k) s += v[j][k] * v[j][k]; }
                const float rs = rsqrtf(wave_sum(s) * (1.f / DM) + EPS);
                if (q == 0 || m2 != m) {
#pragma unroll
                for (int j = 0; j < 2; ++j) { const f32x4 g0 = gf[128 * j], g1 = gf[128 * j + 1];
                    orow[128 * j] = (f32x4){v[j][0] * rs * g0[0], v[j][1] * rs * g0[1], v[j][2] * rs * g0[2], v[j][3] * rs * g0[3]};
                    orow[128 * j + 1] = (f32x4){v[j][4] * rs * g1[0], v[j][5] * rs * g1[1], v[j][6] * rs * g1[2], v[j][7] * rs * g1[3]}; } } } } }
    }
}

extern "C" void kernel_launch(void* const* d_in, const int* in_sizes, int n_in, void* d_out, int out_size, void* d_ws, size_t ws_size, hipStream_t stream) {
    static int grid = 0;
    if (grid == 0) {
        if (n_in != 24 || out_size != MTOK * DM || ws_size < WS_END) { fprintf(stderr, "kernel_launch: unexpected problem: n_in %d out %d ws %zu\n", n_in, out_size, ws_size); grid = -1; return; }
        int dev = 0, cus = 0, per_cu = 0;
        (void)hipGetDevice(&dev); (void)hipDeviceGetAttribute(&cus, hipDeviceAttributeMultiprocessorCount, dev);
        if (hipFuncSetAttribute((const void*)hymba_fwd, hipFuncAttributeMaxDynamicSharedMemorySize, LDS_BYTES) != hipSuccess) { fprintf(stderr, "kernel_launch: hipFuncSetAttribute failed\n"); grid = -1; return; }
        if (hipOccupancyMaxActiveBlocksPerMultiprocessor(&per_cu, (const void*)hymba_fwd, 512, LDS_BYTES) != hipSuccess || per_cu < 1) { fprintf(stderr, "kernel_launch: occupancy query says %d\n", per_cu); per_cu = 1; }
        (void)hipGetLastError();
        grid = cus * 1;
        if (grid < 128) { fprintf(stderr, "kernel_launch: needs >= 128 CUs (phase D's factor table holds 4 units per workgroup), got %d\n", grid); grid = -1; return; }
        fprintf(stderr, "kernel_launch: cus %d per_cu %d grid %d\n", cus, per_cu, grid);
    }
    if (grid < 0) return;
#if MK_MULTI
    if (hipMemsetAsync((char*)d_ws + WS_CTL, 0, CTL_ZERO_BYTES, stream) != hipSuccess) { fprintf(stderr, "kernel_launch: memset of the barrier words failed\n"); return; }
#endif
    Args a{};
    for (int i = 0; i < 24; ++i) a.in[i] = (const float*)d_in[i];
    a.out = (float*)d_out; a.ws = (unsigned char*)d_ws;
#if MK_MULTI
    for (int ph = 0; ph < NPHASE; ++ph) { a.ph_lo = ph; a.ph_hi = ph + 1; hipLaunchKernelGGL(hymba_fwd, dim3(grid), dim3(512), LDS_BYTES, stream, a); }
#else
    a.ph_lo = 0; a.ph_hi = NPHASE;
    void* args[] = {&a};
    hipError_t e = hipLaunchCooperativeKernel((const void*)hymba_fwd, dim3(grid), dim3(512), args, LDS_BYTES, stream);
    if (e != hipSuccess) fprintf(stderr, "kernel_launch: cooperative launch failed: %s (grid %d)\n", hipGetErrorString(e), grid);
#endif
}
```

```cpp
#include <hip/hip_runtime.h>
#include <hip/hip_cooperative_groups.h>
#include <cstdio>
#include <cstdint>
namespace cg = cooperative_groups;

#ifndef MK_MULTI
#define MK_MULTI 0
#endif

#ifndef PROBE_REP
#define PROBE_REP 0
#endif
#ifndef PH_MASK
#define PH_MASK 0xFFFF
#endif
#define PH_EN(k) (((PH_MASK) >> (k)) & 1)
#define LAS __attribute__((address_space(3)))
#define GAS __attribute__((address_space(1)))
typedef unsigned short bf16_t;
typedef short bf16x8 __attribute__((ext_vector_type(8)));
typedef short bf16x4 __attribute__((ext_vector_type(4)));
typedef float f32x4 __attribute__((ext_vector_type(4)));
typedef float f32x2 __attribute__((ext_vector_type(2)));
typedef unsigned u32x4 __attribute__((ext_vector_type(4)));
typedef unsigned u32x2 __attribute__((ext_vector_type(2)));

constexpr int DM = 1024, BATCH = 8, SEQ = 4096, DEPTH = 4, MTOK = BATCH * SEQ;
constexpr int SSMW = 512, NG = 32, NS = 64, ATTW = 512, KVW = 128, INW = 1280, FFH = 2816, PLE = 256;
constexpr float EPS = 1e-6f;
constexpr float QSCALE = 0.125f * 1.4426950408889634f;
constexpr float LOG2E = 1.4426950408889634f;

constexpr size_t MiB = 1u << 20;
constexpr size_t WS_SSQ = 472 * MiB;
constexpr size_t WS_BMAT = 4 * MiB;
constexpr size_t WS_CMAT = 5 * MiB;
constexpr size_t WS_LAM = 6 * MiB;
constexpr size_t WS_W = 8 * MiB, W_LAYER = 24 * MiB;
constexpr size_t WO_IN = 0, WO_GLU = 2 * MiB + 512 * 1024, WO_OUT = 3 * MiB, WO_FI = 5 * MiB, WO_FO = 16 * MiB, WO_G = 21 * MiB + 512 * 1024, WO_P = 23 * MiB + 512 * 1024;
constexpr size_t WS_HB = 104 * MiB;
constexpr size_t WS_PB = 168 * MiB;
constexpr size_t WS_PP = 232 * MiB;
constexpr size_t WS_OV = 296 * MiB;
constexpr size_t WS_HID = WS_OV;
constexpr size_t WS_UG = WS_OV, WS_Q = WS_OV + 32 * MiB, WS_K = WS_OV + 64 * MiB, WS_V = WS_OV + 72 * MiB, WS_YG = WS_OV + 80 * MiB, WS_MIX = WS_OV + 112 * MiB;
constexpr size_t WS_SSMW = 478 * MiB;
constexpr size_t WS_END = 510 * MiB;
static_assert(WO_P + (size_t)1024 * 256 * 2 <= W_LAYER, "weight map");
static_assert(WS_HID + (size_t)MTOK * FFH * 2 <= WS_SSQ && WS_MIX + (size_t)MTOK * 1024 * 2 <= WS_SSQ, "ws map");

constexpr int LDS_BYTES = 147456;
constexpr int LDS_FAC_OFF = 131072, LDS_BAR_OFF = 147440;
constexpr size_t WS_CTL = 0, CTL_ZERO_BYTES = 16384;
constexpr int NPHASE = 1 + 7 * DEPTH + 1;

__device__ __forceinline__ unsigned cvt_pk_bf16(float lo, float hi) { unsigned r; asm volatile("v_cvt_pk_bf16_f32 %0, %1, %2" : "=v"(r) : "v"(lo), "v"(hi)); return r; }
__device__ __forceinline__ unsigned f2bf(float f) { unsigned u = __builtin_bit_cast(unsigned, f); return (u + 0x7fffu + ((u >> 16) & 1u)) >> 16; }
__device__ __forceinline__ float bflo(unsigned w) { return __builtin_bit_cast(float, w << 16); }
__device__ __forceinline__ float bfhi(unsigned w) { return __builtin_bit_cast(float, w & 0xffff0000u); }
__device__ __forceinline__ float sigm(float x) { return __builtin_amdgcn_rcpf(1.f + __builtin_amdgcn_exp2f(-LOG2E * x)); }
#define LDS_WAIT() asm volatile("s_waitcnt lgkmcnt(0)" ::: "memory")
#ifndef WT_STORES
#define WT_STORES 0
#endif
__device__ __forceinline__ void st16(void* p, u32x4 v) {
#if WT_STORES
    asm volatile("global_store_dwordx4 %0, %1, off sc0 sc1" :: "v"(p), "v"(v) : "memory");
#else
    *(u32x4*)p = v;
#endif
}
#define LBAR() do { asm volatile("s_waitcnt lgkmcnt(0)" ::: "memory"); __builtin_amdgcn_s_barrier(); asm volatile("" ::: "memory"); } while (0)
typedef unsigned long long ssq_t;
__device__ __forceinline__ void ssq_add(ssq_t* p, float v) { atomicAdd(p, (ssq_t)(v * 268435456.f)); }
__device__ __forceinline__ float ssq_get(const ssq_t* p) { return (float)(*p) * (1.f / 268435456.f); }
__device__ __forceinline__ int opaque_tid() { int t = threadIdx.x; asm volatile("" : "+v"(t)); return t; }

namespace pg8 {
constexpr int BM = 256, BK = 64, HALF = 128, HTB = HALF * BK * 2, STAGE_BYTES = 8 * HTB, NXCD = 8, WGM = 4;
__host__ __device__ __forceinline__ int lds_byte(int r, int c) { const int st = (r >> 4) * 2 + (c >> 5), rr = r & 15, cc = c & 31, ob = rr * 64 + cc * 2; return st * 1024 + (ob ^ (((ob >> 9) & 1) << 5)); }
__host__ __device__ __forceinline__ void stage_rc(int b, int& R, int& C) { const int st = b / 1024, sb = b % 1024, swz = sb ^ (((sb >> 9) & 1) << 5); R = (st >> 1) * 16 + swz / 64; C = (st & 1) * 32 + (swz % 64) / 2; }
__host__ __device__ __forceinline__ int perm32(int rho) { const int n = rho >> 4, i = rho & 15; return 8 * (i >> 2) + 4 * n + (i & 3); }

struct Unit { int pm, pn; };
struct Gemm { const bf16_t* A; const bf16_t* Bt; int M, N, K; };

struct StaticOrder {
    int nM, nN, nwg, G, c;
    __host__ __device__ void init(int M, int N, int G_, int c_) { nM = M / BM; nN = N / BM; nwg = nM * nN; G = G_; c = c_; }
    __host__ __device__ bool next(int i, Unit& u) const {
        const long L = (long)i * G + c; if (L >= nwg) return false;
        int wgid = (int)L; { const int q = nwg / NXCD, r = nwg % NXCD, xcd = wgid % NXCD, off = wgid / NXCD; wgid = (xcd < r ? xcd * (q + 1) : r * (q + 1) + (xcd - r) * q) + off; }
        const int nig = WGM * nN, gid = wgid / nig, fm = gid * WGM, gsz = (nM - fm) < WGM ? (nM - fm) : WGM;
        u.pm = fm + ((wgid % nig) % gsz); u.pn = (wgid % nig) / gsz; return true;
    }
};

template <class Epi>
__device__ __forceinline__ void gemm_phase(LAS unsigned char* lds, const Gemm g, const StaticOrder& S, const Epi& E) {
    const int tid = opaque_tid(), wid = __builtin_amdgcn_readfirstlane(tid >> 6), lane = tid & 63, wr = wid >> 2, wc = wid & 3, fr = lane & 15, fq = lane >> 4;
    const int K = g.K, nt = K / BK;
    unsigned voffA, voffB;
    { int R, C; stage_rc(tid * 16, R, C); const int Rb = Epi::PERM ? ((R & ~31) + perm32(R & 31)) : R;
        voffA = (unsigned)(R * K + C) * 2u; voffB = (unsigned)(Rb * K + C) * 2u; }
    const size_t pstep = (size_t)64 * K * 2;
    const size_t kstep = (size_t)(BK * 2);
    const size_t hstep = (size_t)HALF * K * 2;
    const size_t tstep = 2 * hstep;
    const unsigned ldsw = (unsigned)wid * 1024u;
    const int aoff = lds_byte(wr * 64 + fr, fq * 8), boff = lds_byte(wc * 32 + fr, fq * 8);
#define PG8_SA(b, h) (((b) * 2 + (h)) * HTB)
#define PG8_SB(b, h) ((4 + (b) * 2 + (h)) * HTB)
#define PG8_STAGE(bufoff, gbase, voff) do { _Pragma("unroll") for (int _i = 0; _i < 2; ++_i) \
        __builtin_amdgcn_global_load_lds((const unsigned*)((const char*)(gbase) + _i * pstep + (voff)), (LAS unsigned*)(lds + (bufoff) + ldsw + _i * 8192), 16, 0, 0); } while (0)
#define PG8_LDA(dst, b, h) do { _Pragma("unroll") for (int m = 0; m < 4; ++m) _Pragma("unroll") for (int k = 0; k < 2; ++k) dst[m][k] = *(const LAS bf16x8*)(lds + PG8_SA(b, h) + aoff + m * 2048 + k * 1024); } while (0)
#define PG8_LDB(dst, b, h) do { _Pragma("unroll") for (int n = 0; n < 2; ++n) _Pragma("unroll") for (int k = 0; k < 2; ++k) dst[n][k] = *(const LAS bf16x8*)(lds + PG8_SB(b, h) + boff + n * 2048 + k * 1024); } while (0)
#define PG8_MMA(ai, bj, At, Bt) do { __builtin_amdgcn_s_setprio(1); _Pragma("unroll") for (int m = 0; m < 4; ++m) _Pragma("unroll") for (int n = 0; n < 2; ++n) _Pragma("unroll") for (int k = 0; k < 2; ++k) \
        acc[ai][bj][m][n] = __builtin_amdgcn_mfma_f32_16x16x32_bf16(Bt[n][k], At[m][k], acc[ai][bj][m][n], 0, 0, 0); __builtin_amdgcn_s_setprio(0); } while (0)
#define PG8_WAIT_V(n) asm volatile("s_waitcnt vmcnt(" #n ")" ::: "memory")
#define PG8_WAIT_L(n) asm volatile("s_waitcnt lgkmcnt(" #n ")" ::: "memory")
#define PG8_BAR __builtin_amdgcn_s_barrier()
#define PG8_SCHED __builtin_amdgcn_sched_barrier(0)
    Unit cur, nxt; int ui = 0;
    if (!S.next(0, cur)) return;
    f32x4 acc[2][2][4][2];
#pragma unroll
    for (int a = 0; a < 2; ++a)
#pragma unroll
        for (int b = 0; b < 2; ++b)
#pragma unroll
            for (int m = 0; m < 4; ++m)
#pragma unroll
                for (int n = 0; n < 2; ++n) acc[a][b][m][n] = (f32x4){0.f, 0.f, 0.f, 0.f};
    bf16x8 At[4][2], B0[2][2], B1[2][2];
    const char* cA = (const char*)g.A + (size_t)cur.pm * tstep; const char* cB = (const char*)g.Bt + (size_t)cur.pn * tstep;
    PG8_STAGE(PG8_SB(0, 0), cB, voffB); PG8_STAGE(PG8_SB(0, 1), cB + hstep, voffB); PG8_STAGE(PG8_SA(0, 0), cA, voffA); PG8_STAGE(PG8_SA(0, 1), cA + hstep, voffA);
    if (wr == 1) PG8_BAR;
    PG8_WAIT_V(2); PG8_BAR;
    PG8_STAGE(PG8_SB(1, 0), cB + kstep, voffB); PG8_STAGE(PG8_SA(1, 0), cA + kstep, voffA); PG8_STAGE(PG8_SB(1, 1), cB + hstep + kstep, voffB);
    PG8_WAIT_V(6); PG8_BAR;
    for (;;) {
        const bool has_next = S.next(ui + 1, nxt);
        const char* nA = has_next ? (const char*)g.A + (size_t)nxt.pm * tstep : cA; const char* nB = has_next ? (const char*)g.Bt + (size_t)nxt.pn * tstep : cB;
#pragma unroll 1
        for (int t = 0; t < nt; t += 2) {
            const bool last = (t == nt - 2);
            const char* a1 = cA + (size_t)(t + 1) * kstep;
            const char* a2 = last ? nA : cA + (size_t)(t + 2) * kstep; const char* b2 = last ? nB : cB + (size_t)(t + 2) * kstep;
            const char* a3 = a2 + kstep; const char* b3 = b2 + kstep;
            if constexpr (Epi::MID) { if (t == (nt >> 1)) E.mid(acc, ui, wr, wc, fr, fq); }
            PG8_LDB(B0, 0, 0); PG8_LDB(B1, 0, 1); PG8_SCHED; PG8_LDA(At, 0, 0); PG8_STAGE(PG8_SA(1, 1), a1 + hstep, voffA);
            PG8_WAIT_V(8); PG8_WAIT_L(0); PG8_BAR; PG8_MMA(0, 0, At, B0); PG8_MMA(0, 1, At, B1); PG8_BAR; PG8_SCHED;
            PG8_LDA(At, 0, 1); PG8_STAGE(PG8_SB(0, 0), b2, voffB); PG8_STAGE(PG8_SB(0, 1), b2 + hstep, voffB); PG8_STAGE(PG8_SA(0, 0), a2, voffA);
            PG8_WAIT_V(8); PG8_WAIT_L(0); PG8_BAR; PG8_MMA(1, 0, At, B0); PG8_MMA(1, 1, At, B1); PG8_BAR; PG8_SCHED;
            PG8_LDB(B0, 1, 0); PG8_LDB(B1, 1, 1); PG8_SCHED; PG8_LDA(At, 1, 0); PG8_STAGE(PG8_SA(0, 1), a2 + hstep, voffA);
            PG8_WAIT_V(8); PG8_WAIT_L(0); PG8_BAR; PG8_MMA(0, 0, At, B0); PG8_MMA(0, 1, At, B1); PG8_BAR; PG8_SCHED;
            PG8_LDA(At, 1, 1); PG8_STAGE(PG8_SB(1, 0), b3, voffB); PG8_STAGE(PG8_SB(1, 1), b3 + hstep, voffB); PG8_STAGE(PG8_SA(1, 0), a3, voffA);
            PG8_WAIT_V(8); PG8_WAIT_L(0); PG8_BAR; PG8_MMA(1, 0, At, B0); PG8_MMA(1, 1, At, B1); PG8_BAR; PG8_SCHED;
        }
        if (wr == 0) PG8_BAR;
        E(acc, cur, ui, wr, wc, fr, fq);
        if (!has_next) break;
#pragma unroll
        for (int a = 0; a < 2; ++a)
#pragma unroll
            for (int b = 0; b < 2; ++b)
#pragma unroll
                for (int m = 0; m < 4; ++m)
#pragma unroll
                    for (int n = 0; n < 2; ++n) acc[a][b][m][n] = (f32x4){0.f, 0.f, 0.f, 0.f};
        cur = nxt; cA = nA; cB = nB; ++ui;
        if (wr == 1) PG8_BAR;
    }
    PG8_WAIT_V(0);
    PG8_BAR;
#undef PG8_SA
#undef PG8_SB
#undef PG8_STAGE
#undef PG8_LDA
#undef PG8_LDB
#undef PG8_MMA
#undef PG8_WAIT_V
#undef PG8_WAIT_L
#undef PG8_BAR
#undef PG8_SCHED
}

typedef f32x4 Acc[2][2][4][2];

struct EpiInProj {
    static constexpr bool PERM = true, MID = false;
    const ssq_t* ssq; bf16_t *UG, *Q, *K, *V; const LAS float* tab;
    __device__ __forceinline__ void operator()(const Acc& acc, const Unit& u, int ui, int wr, int wc, int fr, int fq) const {
        const int row0 = u.pm * BM + wr * 64 + fr;
#pragma unroll
        for (int ai = 0; ai < 2; ++ai)
#pragma unroll
            for (int m = 0; m < 4; ++m) {
                const int row = row0 + ai * HALF + m * 16;
                const float rs = tab ? tab[ui * 256 + wr * 64 + fr + ai * HALF + m * 16] : rsqrtf(ssq_get(ssq + row) * (1.f / 1024.f) + EPS);
#pragma unroll
                for (int bj = 0; bj < 2; ++bj) {
                    const int c = u.pn * BM + bj * HALF + wc * 32 + 8 * fq;
                    float sc = rs; bf16_t* dst;
                    if (c < 512) dst = UG + ((size_t)(c >> 4) * MTOK + row) * 16 + (c & 15);
                    else if (c < 1024) { dst = Q + (size_t)row * 512 + (c - 512); sc *= QSCALE; }
                    else if (c < 1152) dst = K + (size_t)row * 128 + (c - 1024);
                    else dst = V + (size_t)row * 128 + (c - 1152);
                    const f32x4 v0 = acc[ai][bj][m][0] * sc, v1 = acc[ai][bj][m][1] * sc;
                    u32x4 w; w.x = cvt_pk_bf16(v0[0], v0[1]); w.y = cvt_pk_bf16(v0[2], v0[3]); w.z = cvt_pk_bf16(v1[0], v1[1]); w.w = cvt_pk_bf16(v1[2], v1[3]);
                    st16(dst, w);
                }
            }
    }
};

struct EpiGlu {
    static constexpr bool PERM = true, MID = false;
    const bf16_t* YG; bf16_t* MIX; ssq_t* ssq;
    __device__ __forceinline__ void operator()(const Acc& acc, const Unit& u, int ui, int wr, int wc, int fr, int fq) const {
        const int row0 = u.pm * BM + wr * 64 + fr;
#pragma unroll
        for (int ai = 0; ai < 2; ++ai)
#pragma unroll
            for (int m = 0; m < 4; ++m) {
                const int row = row0 + ai * HALF + m * 16; float part = 0.f;
#pragma unroll
                for (int bj = 0; bj < 2; ++bj) {
                    const int c = u.pn * BM + bj * HALF + wc * 32 + 8 * fq;
                    const u32x4 yw = *(const u32x4*)(YG + (size_t)row * 512 + c);
                    const f32x4 z0 = acc[ai][bj][m][0], z1 = acc[ai][bj][m][1];
                    float o[8];
                    o[0] = bflo(yw.x) * sigm(z0[0]); o[1] = bfhi(yw.x) * sigm(z0[1]); o[2] = bflo(yw.y) * sigm(z0[2]); o[3] = bfhi(yw.y) * sigm(z0[3]);
                    o[4] = bflo(yw.z) * sigm(z1[0]); o[5] = bfhi(yw.z) * sigm(z1[1]); o[6] = bflo(yw.w) * sigm(z1[2]); o[7] = bfhi(yw.w) * sigm(z1[3]);
#pragma unroll
                    for (int j = 0; j < 8; ++j) part += o[j] * o[j];
                    u32x4 w; w.x = cvt_pk_bf16(o[0], o[1]); w.y = cvt_pk_bf16(o[2], o[3]); w.z = cvt_pk_bf16(o[4], o[5]); w.w = cvt_pk_bf16(o[6], o[7]);
                    st16(MIX + (size_t)row * 1024 + c, w);
                }
                part += __shfl_xor(part, 16); part += __shfl_xor(part, 32);
                if (fq == 0) ssq_add(ssq + row, part);
            }
    }
};

struct EpiPlain {
    static constexpr bool PERM = true, MID = false;
    bf16_t* O;
    __device__ __forceinline__ void operator()(const Acc& acc, const Unit& u, int ui, int wr, int wc, int fr, int fq) const {
        const int row0 = u.pm * BM + wr * 64 + fr;
#pragma unroll
        for (int ai = 0; ai < 2; ++ai)
#pragma unroll
            for (int m = 0; m < 4; ++m) {
                const int row = row0 + ai * HALF + m * 16;
#pragma unroll
                for (int bj = 0; bj < 2; ++bj) {
                    const int c = u.pn * BM + bj * HALF + wc * 32 + 8 * fq;
                    const f32x4 v0 = acc[ai][bj][m][0], v1 = acc[ai][bj][m][1];
                    u32x4 w; w.x = cvt_pk_bf16(v0[0], v0[1]); w.y = cvt_pk_bf16(v0[2], v0[3]); w.z = cvt_pk_bf16(v1[0], v1[1]); w.w = cvt_pk_bf16(v1[2], v1[3]);
                    st16(O + (size_t)row * 1024 + c, w);
                }
            }
    }
};

struct EpiFfnIn {
    static constexpr bool PERM = true, MID = false;
    const ssq_t* ssq; bf16_t* HID; const LAS float* tab;
    __device__ __forceinline__ void operator()(const Acc& acc, const Unit& u, int ui, int wr, int wc, int fr, int fq) const {
        const int row0 = u.pm * BM + wr * 64 + fr; const int c = u.pn * HALF + wc * 32 + 8 * fq;
#pragma unroll
        for (int ai = 0; ai < 2; ++ai)
#pragma unroll
            for (int m = 0; m < 4; ++m) {
                const int row = row0 + ai * HALF + m * 16;
                const float rs = tab ? tab[ui * 256 + wr * 64 + fr + ai * HALF + m * 16] : rsqrtf(ssq_get(ssq + row) * (1.f / 1024.f) + EPS);
                const float c1 = -LOG2E * rs, c2 = rs * rs;
                float o[8];
#pragma unroll
                for (int n = 0; n < 2; ++n)
#pragma unroll
                    for (int j = 0; j < 4; j += 2) { const f32x2 g2 = {acc[ai][0][m][n][j], acc[ai][0][m][n][j + 1]}, u2 = {acc[ai][1][m][n][j], acc[ai][1][m][n][j + 1]};
                        const f32x2 ea = g2 * c1; f32x2 dn; dn.x = __builtin_amdgcn_exp2f(ea.x); dn.y = __builtin_amdgcn_exp2f(ea.y); dn = dn + 1.0f;
                        f32x2 rc; rc.x = __builtin_amdgcn_rcpf(dn.x); rc.y = __builtin_amdgcn_rcpf(dn.y);
                        const f32x2 r2 = (g2 * u2) * (rc * c2); o[n * 4 + j] = r2.x; o[n * 4 + j + 1] = r2.y; }
                u32x4 w; w.x = cvt_pk_bf16(o[0], o[1]); w.y = cvt_pk_bf16(o[2], o[3]); w.z = cvt_pk_bf16(o[4], o[5]); w.w = cvt_pk_bf16(o[6], o[7]);
                st16(HID + (size_t)row * FFH + c, w);
            }
    }
};

template <int MODE> struct EpiRes {
    static constexpr bool PERM = true, MID = (MODE == 1);
    const bf16_t* HR; bf16_t* HW; ssq_t* ssq_out; const ssq_t* ssq_a; const bf16_t* PP; const LAS f32x2* fac; const LAS float* tab;
    __device__ __forceinline__ void mid(Acc& acc, int ui, int wr, int wc, int fr, int fq) const {
        const LAS f32x2* T = fac + (ui & 3) * 256 + wr * 64 + fr;
#pragma unroll
        for (int ai = 0; ai < 2; ++ai)
#pragma unroll
            for (int m = 0; m < 4; ++m) {
                const float f = T[ai * HALF + m * 16].x;
#pragma unroll
                for (int bj = 0; bj < 2; ++bj)
#pragma unroll
                    for (int n = 0; n < 2; ++n) acc[ai][bj][m][n] = acc[ai][bj][m][n] * f;
            }
    }
    __device__ __forceinline__ void operator()(const Acc& acc, const Unit& u, int ui, int wr, int wc, int fr, int fq) const {
        const int row0 = u.pm * BM + wr * 64 + fr; const int col0 = u.pn * BM + wc * 32 + 8 * fq;
        constexpr int NB = (MODE == 2) ? 2 : 4;
#pragma unroll
        for (int g0 = 0; g0 < 8; g0 += NB) {
            u32x4 hw[NB][2], pw[(MODE == 2) ? NB : 1][2]; float rs[NB];
#pragma unroll
            for (int gi = 0; gi < NB; ++gi) { const int g = g0 + gi, ai = g >> 2, m = g & 3;
                const int row = row0 + ai * HALF + m * 16; const size_t off = (size_t)row * 1024 + col0;
#pragma unroll
                for (int bj = 0; bj < 2; ++bj) { hw[gi][bj] = *(const u32x4*)(HR + off + bj * HALF); if (MODE == 2) pw[gi][bj] = *(const u32x4*)(PP + off + bj * HALF); }
                rs[gi] = 1.f;
                if (MODE == 1) rs[gi] = fac[(ui & 3) * 256 + wr * 64 + fr + ai * HALF + m * 16].y;
                if (MODE == 2) rs[gi] = tab ? tab[ui * 256 + wr * 64 + fr + ai * HALF + m * 16] : rsqrtf(ssq_get(ssq_a + row) * (1.f / 1024.f) + EPS);
            }
#pragma unroll
            for (int gi = 0; gi < NB; ++gi) { const int g = g0 + gi, ai = g >> 2, m = g & 3;
                const int row = row0 + ai * HALF + m * 16; const size_t off = (size_t)row * 1024 + col0; float part = 0.f;
                const float r = rs[gi];
#pragma unroll
                for (int bj = 0; bj < 2; ++bj) {
                    const size_t o2 = off + bj * HALF;
                    const u32x4 h4 = hw[gi][bj];
                    const f32x4 a0 = acc[ai][bj][m][0], a1 = acc[ai][bj][m][1];
                    float d[8] = {a0[0], a0[1], a0[2], a0[3], a1[0], a1[1], a1[2], a1[3]};
                    if (MODE == 1) {
#pragma unroll
                        for (int j = 0; j < 8; ++j) d[j] *= r;
                    }
                    if (MODE == 2) { const u32x4 p4 = pw[gi][bj];
                        const float pp[8] = {bflo(p4.x), bfhi(p4.x), bflo(p4.y), bfhi(p4.y), bflo(p4.z), bfhi(p4.z), bflo(p4.w), bfhi(p4.w)};
#pragma unroll
                        for (int j = 0; j < 8; ++j) d[j] = sigm(d[j] * r) * pp[j]; }
                    float o[8];
                    o[0] = bflo(h4.x) + d[0]; o[1] = bfhi(h4.x) + d[1]; o[2] = bflo(h4.y) + d[2]; o[3] = bfhi(h4.y) + d[3];
                    o[4] = bflo(h4.z) + d[4]; o[5] = bfhi(h4.z) + d[5]; o[6] = bflo(h4.w) + d[6]; o[7] = bfhi(h4.w) + d[7];
                    u32x4 w; w.x = cvt_pk_bf16(o[0], o[1]); w.y = cvt_pk_bf16(o[2], o[3]); w.z = cvt_pk_bf16(o[4], o[5]); w.w = cvt_pk_bf16(o[6], o[7]);
                    st16(HW + o2, w);
#pragma unroll
                    for (int j = 0; j < 8; ++j) part += o[j] * o[j];
                }
                part += __shfl_xor(part, 16); part += __shfl_xor(part, 32);
                if (fq == 0) ssq_add(ssq_out + row, part);
            }
            asm volatile("" ::: "memory");
        }
    }
};
}

struct Args { const float* in[24]; float* out; unsigned char* ws; int ph_lo, ph_hi; };
enum { I_X = 0, I_P, I_NMIX, I_WIN, I_ARE, I_AIM, I_LDT, I_BRE, I_BIM, I_CRE, I_CIM, I_D, I_WGLU, I_SINK, I_NSSM, I_NATT, I_WOUT, I_NFFN, I_WFI, I_WFO, I_NPLE, I_WG, I_WP, I_NFIN };

__device__ __forceinline__ ssq_t* ssq_ptr(unsigned char* ws, int l, int type) { return (ssq_t*)(ws + WS_SSQ) + ((size_t)l * 6 + type) * MTOK; }

__device__ __forceinline__ void tr_item(const float* W, int K, int N, bf16_t* WT, const float* s0, const float* s1, int ksplit, bool ffn_map, LAS float* scr, int item, int lane) {
    const int nblk = N / 32, kb = item / nblk, nb = item % nblk, k0 = 64 * kb, n0 = 32 * nb;
    float wv[32];
#pragma unroll
    for (int i = 0; i < 32; ++i) { const int kk = 2 * i + (lane >> 5); wv[i] = W[(size_t)(k0 + kk) * N + n0 + (lane & 31)]; }
    if (s0) {
#pragma unroll
        for (int i = 0; i < 32; ++i) { const int k = k0 + 2 * i + (lane >> 5); const float* sp = (k < ksplit) ? (s0 + k) : (s1 + (k - ksplit)); wv[i] *= *sp; } }
#pragma unroll
    for (int i = 0; i < 32; ++i) { const int kk = 2 * i + (lane >> 5); scr[kk * 33 + (lane & 31)] = wv[i]; }
    LDS_WAIT();
    int nr0 = n0;
    if (ffn_map) { if (n0 < FFH) nr0 = 256 * (n0 / 128) + (n0 % 128); else { const int j = n0 - FFH; nr0 = 256 * (j / 128) + 128 + (j % 128); } }
    const int c = lane & 7;
#pragma unroll
    for (int j = 0; j < 4; ++j) { const int n = (lane >> 3) + 8 * j; const LAS float* s = scr + (8 * c) * 33 + n;
        u32x4 o; o.x = cvt_pk_bf16(s[0 * 33], s[1 * 33]); o.y = cvt_pk_bf16(s[2 * 33], s[3 * 33]); o.z = cvt_pk_bf16(s[4 * 33], s[5 * 33]); o.w = cvt_pk_bf16(s[6 * 33], s[7 * 33]);
        *(u32x4*)(WT + (size_t)(nr0 + n) * K + k0 + 8 * c) = o; }
    LDS_WAIT();
}

__device__ __forceinline__ float wave_sum(float v) {
#pragma unroll
    for (int o = 1; o < 64; o <<= 1) v += __shfl_xor(v, o);
    return v;
}

__device__ __forceinline__ void sincos_acc(float x, float& s, float& c) {
    const float nf = rintf(x * 0.6366197723675814f); const int n = (int)nf;
    float r = __builtin_fmaf(nf, -1.5707962513e+00f, x); r = __builtin_fmaf(nf, -7.5497894159e-08f, r); r = __builtin_fmaf(nf, -5.3903029534e-15f, r);
    const float r2 = r * r;
    float sp = __builtin_fmaf(r2, 2.7557319224e-06f, -1.9841269841e-04f); sp = __builtin_fmaf(sp, r2, 8.3333333333e-03f); sp = __builtin_fmaf(sp, r2, -1.6666666667e-01f); sp = __builtin_fmaf(sp * r2, r, r);
    float cp = __builtin_fmaf(r2, -2.7557319224e-07f, 2.4801587302e-05f); cp = __builtin_fmaf(cp, r2, -1.3888888889e-03f); cp = __builtin_fmaf(cp, r2, 4.1666666667e-02f); cp = __builtin_fmaf(cp, r2, -0.5f); cp = __builtin_fmaf(cp, r2, 1.0f);
    const int q = n & 3;
    const float ss = (q & 1) ? cp : sp, cc = (q & 1) ? sp : cp;
    s = (q & 2) ? -ss : ss; c = ((q + 1) & 2) ? -cc : cc;
}

__device__ __forceinline__ void prologue(const Args& a, LAS unsigned char* lds, unsigned char* ws) {
    const int tid = opaque_tid(), lane = tid & 63, wave = tid >> 6;
    const int G = gridDim.x, gw = blockIdx.x * 8 + wave, NGW = G * 8;
    const int gtid = blockIdx.x * 512 + tid, NT = G * 512;
    LAS float* scr = (LAS float*)(lds + wave * 16384);
    constexpr int IT_IN = 16 * 40, IT_GLU = 8 * 16, IT_OUT = 16 * 32, IT_FI = 16 * 176, IT_FO = 44 * 32, IT_G = 16 * 32, IT_P = 4 * 32;
    constexpr int IT_L = IT_IN + IT_GLU + IT_OUT + IT_FI + IT_FO + IT_G + IT_P;
    for (int it = gw; it < IT_L * DEPTH; it += NGW) {
        const int l = it / IT_L; int r = it % IT_L;
        unsigned char* wl = ws + WS_W + (size_t)l * W_LAYER;
        if (r < IT_IN) { tr_item(a.in[I_WIN] + (size_t)l * DM * INW, DM, INW, (bf16_t*)(wl + WO_IN), a.in[I_NMIX] + l * DM, a.in[I_NMIX] + l * DM, DM, false, scr, r, lane); continue; } r -= IT_IN;
        if (r < IT_GLU) { tr_item(a.in[I_WGLU] + (size_t)l * SSMW * SSMW, SSMW, SSMW, (bf16_t*)(wl + WO_GLU), nullptr, nullptr, 0, false, scr, r, lane); continue; } r -= IT_GLU;
        if (r < IT_OUT) { tr_item(a.in[I_WOUT] + (size_t)l * DM * DM, DM, DM, (bf16_t*)(wl + WO_OUT), a.in[I_NSSM] + l * SSMW, a.in[I_NATT] + l * ATTW, SSMW, false, scr, r, lane); continue; } r -= IT_OUT;
        if (r < IT_FI) { tr_item(a.in[I_WFI] + (size_t)l * DM * 2 * FFH, DM, 2 * FFH, (bf16_t*)(wl + WO_FI), a.in[I_NFFN] + l * DM, a.in[I_NFFN] + l * DM, DM, true, scr, r, lane); continue; } r -= IT_FI;
        if (r < IT_FO) { tr_item(a.in[I_WFO] + (size_t)l * FFH * DM, FFH, DM, (bf16_t*)(wl + WO_FO), nullptr, nullptr, 0, false, scr, r, lane); continue; } r -= IT_FO;
        if (r < IT_G) { tr_item(a.in[I_WG] + (size_t)l * DM * DM, DM, DM, (bf16_t*)(wl + WO_G), a.in[I_NPLE] + l * DM, a.in[I_NPLE] + l * DM, DM, false, scr, r, lane); continue; } r -= IT_G;
        tr_item(a.in[I_WP] + (size_t)l * PLE * DM, PLE, DM, (bf16_t*)(wl + WO_P), nullptr, nullptr, 0, false, scr, r, lane);
    }
    {
        ssq_t* ssq0 = ssq_ptr(ws, 0, 0); bf16_t* HB = (bf16_t*)(ws + WS_HB);
        for (int m = gw; m < MTOK; m += 2 * NGW) {
            const int m2 = m + NGW;
            const bool has2 = m2 < MTOK; const int mm2 = has2 ? m2 : m;
            const f32x4* xr = (const f32x4*)(a.in[I_X] + (size_t)m * DM) + lane; const f32x4* xr2 = (const f32x4*)(a.in[I_X] + (size_t)mm2 * DM) + lane;
            f32x4 v[4], v2[4];
#pragma unroll
            for (int j = 0; j < 4; ++j) { v[j] = xr[64 * j]; v2[j] = xr2[64 * j]; }
            u32x2* hb = (u32x2*)(HB + (size_t)m * DM) + lane; u32x2* hb2 = (u32x2*)(HB + (size_t)mm2 * DM) + lane;
            float s = 0.f, s2 = 0.f;
#pragma unroll
            for (int j = 0; j < 4; ++j) { u32x2 w; w.x = cvt_pk_bf16(v[j][0], v[j][1]); w.y = cvt_pk_bf16(v[j][2], v[j][3]); hb[64 * j] = w; s += (v[j][0] * v[j][0] + v[j][1] * v[j][1]) + (v[j][2] * v[j][2] + v[j][3] * v[j][3]);
                u32x2 w2; w2.x = cvt_pk_bf16(v2[j][0], v2[j][1]); w2.y = cvt_pk_bf16(v2[j][2], v2[j][3]); if (has2) hb2[64 * j] = w2; s2 += (v2[j][0] * v2[j][0] + v2[j][1] * v2[j][1]) + (v2[j][2] * v2[j][2] + v2[j][3] * v2[j][3]); }
            s = wave_sum(s); s2 = wave_sum(s2);
            if (lane == 0) { ssq0[m] = (ssq_t)(s * 268435456.f); if (has2) ssq0[m2] = (ssq_t)(s2 * 268435456.f); }
        }
    }
    {
        const f32x4* p4 = (const f32x4*)a.in[I_P]; u32x4* pb = (u32x4*)(ws + WS_PB);
        const int n8 = DEPTH * MTOK * PLE / 8;
#pragma unroll 4
        for (int i = gtid; i < n8; i += NT) { const f32x4 v0 = p4[2 * i], v1 = p4[2 * i + 1]; u32x4 w; w.x = cvt_pk_bf16(v0[0], v0[1]); w.y = cvt_pk_bf16(v0[2], v0[3]); w.z = cvt_pk_bf16(v1[0], v1[1]); w.w = cvt_pk_bf16(v1[2], v1[3]); pb[i] = w; }
    }
    {
        u32x4* z = (u32x4*)(ws + WS_SSQ); const int n4 = DEPTH * 6 * MTOK / 2;
        for (int i = gtid; i < n4; i += NT) if (i >= MTOK / 2) z[i] = (u32x4){0u, 0u, 0u, 0u};
    }
    {
        __syncthreads();
        LAS f32x2* LP = (LAS f32x2*)(lds); LAS f32x2* BB = (LAS f32x2*)(lds + 8704); LAS f32x2* CC = (LAS f32x2*)(lds + 16896); LAS float* KT = (LAS float*)(lds + 25088);
        for (int item = blockIdx.x; item < 2 * DEPTH * NG; item += G) {
            const int lg = item >> 1, part = item & 1, l = lg >> 5;
            if (tid < 64) { const int p = tid;
                const float dt = __expf(a.in[I_LDT][lg]);
                const float ar = a.in[I_ARE][lg * NS + p], ai = a.in[I_AIM][lg * NS + p];
                const float mag = __expf(ar * dt); float sn, cs; sincos_acc(ai * dt, sn, cs);
                const float lr = mag * cs, li = mag * sn;
                const float den = ar * ar + ai * ai, nr = lr - 1.f, ni = li;
                const float fr = (nr * ar + ni * ai) / den, fi = (ni * ar - nr * ai) / den;
                float pr = 1.f, pi = 0.f;
                for (int k = 0; k <= 16; ++k) { LP[k * 64 + p] = (f32x2){pr, pi}; const float tr = pr * lr - pi * li, ti = pr * li + pi * lr; pr = tr; pi = ti; }
                const float* bre = a.in[I_BRE] + ((size_t)lg * NS + p) * 16; const float* bim = a.in[I_BIM] + ((size_t)lg * NS + p) * 16;
#pragma unroll
                for (int h = 0; h < 16; ++h) { const float br = bre[h], bi = bim[h]; BB[p * 16 + h] = (f32x2){fr * br - fi * bi, fr * bi + fi * br}; }
            }
            for (int i = tid; i < 1024; i += 512) CC[i] = (f32x2){a.in[I_CRE][(size_t)lg * 1024 + i], a.in[I_CIM][(size_t)lg * 1024 + i]};
            __syncthreads();
            bf16_t* Mg = (bf16_t*)(ws + WS_SSMW) + (size_t)lg * 131072;
            if (part == 0) {
                for (int i = 0; i < 8; ++i) { const int idx = tid + 512 * i, tau = idx >> 8, h = (idx >> 4) & 15, hp = idx & 15; float acc = 0.f;
                    for (int p = 0; p < 64; ++p) { const f32x2 L = LP[tau * 64 + p], Bp = BB[p * 16 + hp], C = CC[h * 64 + p];
                        const float Pr = L.x * Bp.x - L.y * Bp.y, Pi = L.x * Bp.y + L.y * Bp.x; acc += C.x * Pr - C.y * Pi; }
                    if (tau == 0 && h == hp) acc += a.in[I_D][l * SSMW + (lg & 31) * 16 + h];
                    KT[idx] = acc; }
                __syncthreads();
                for (int i = 0; i < 16; ++i) { const int q = tid + 512 * i, row = q >> 5, trow = row >> 4, h = row & 15, cp = q & 31, sc = cp >> 1, hp0 = (cp & 1) * 8;
                    float v[8];
#pragma unroll
                    for (int j = 0; j < 8; ++j) v[j] = (sc <= trow) ? KT[((trow - sc) << 8) + (h << 4) + hp0 + j] : 0.f;
                    u32x4 w; w.x = cvt_pk_bf16(v[0], v[1]); w.y = cvt_pk_bf16(v[2], v[3]); w.z = cvt_pk_bf16(v[4], v[5]); w.w = cvt_pk_bf16(v[6], v[7]);
                    *(u32x4*)(Mg + (size_t)row * 256 + cp * 8) = w; }
            } else {
                if (tid < 64) ((f32x2*)(ws + WS_LAM))[lg * NS + tid] = LP[16 * 64 + tid];
                for (int i = 0; i < 8; ++i) { const int q = tid + 512 * i, row = q >> 4, trow = row >> 4, h = row & 15, p0 = (q & 15) * 4;
                    unsigned wv[4];
#pragma unroll
                    for (int j = 0; j < 4; ++j) { const f32x2 L = LP[(trow + 1) * 64 + p0 + j], C = CC[h * 64 + p0 + j]; wv[j] = cvt_pk_bf16(C.x * L.x - C.y * L.y, -(C.x * L.y + C.y * L.x)); }
                    *(u32x4*)(Mg + 65536 + (size_t)row * 128 + p0 * 2) = (u32x4){wv[0], wv[1], wv[2], wv[3]}; }
                for (int i = 0; i < 8; ++i) { const int q = tid + 512 * i, n = q >> 5, cp = q & 31, sc = cp >> 1, hp0 = (cp & 1) * 8, p = n >> 1, im = n & 1;
                    const f32x2 L = LP[(15 - sc) * 64 + p]; float v[8];
#pragma unroll
                    for (int j = 0; j < 8; ++j) { const f32x2 Bp = BB[p * 16 + hp0 + j]; v[j] = im ? (L.x * Bp.y + L.y * Bp.x) : (L.x * Bp.x - L.y * Bp.y); }
                    u32x4 w; w.x = cvt_pk_bf16(v[0], v[1]); w.y = cvt_pk_bf16(v[2], v[3]); w.z = cvt_pk_bf16(v[4], v[5]); w.w = cvt_pk_bf16(v[6], v[7]);
                    *(u32x4*)(Mg + 98304 + (size_t)n * 256 + cp * 8) = w; }
            }
            __syncthreads();
        }
    }
}

constexpr int SS_STRIDE = 528;
constexpr int SS_UL = 0, SS_SL = 128 * SS_STRIDE;
static_assert(2 * 128 * SS_STRIDE <= LDS_BAR_OFF, "S5 LDS map");
__device__ __forceinline__ void ssm_item(LAS unsigned char* lds, int b, int g, int l, const Args& a, unsigned char* ws) {
    const int tid = opaque_tid(), lane = tid & 63, w = __builtin_amdgcn_readfirstlane(tid >> 6), fr = lane & 15, fq = lane >> 4;
    const int lg = l * NG + g;
    const bf16_t* U = (const bf16_t*)(ws + WS_UG) + ((size_t)g * MTOK + (size_t)b * SEQ) * 16;
    const bf16_t* Mg = (const bf16_t*)(ws + WS_SSMW) + (size_t)lg * 131072; const bf16_t* Rg = Mg + 65536; const bf16_t* W16 = Mg + 98304;
    bf16_t* YG = (bf16_t*)(ws + WS_YG) + (size_t)b * SEQ * 512 + g * 16;
    const int nt0 = w, nt1 = 15 - w;
    const f32x2 L16 = ((const f32x2*)(ws + WS_LAM))[lg * NS + lane];
    const f32x2 lrr = {L16.x, L16.x}, lii = {-L16.y, L16.y};
    f32x2 x = {0.f, 0.f};
    bf16x8 bfr[8];
#pragma unroll
    for (int ks = 0; ks < 8; ++ks) bfr[ks] = *(const bf16x8*)(W16 + (size_t)(16 * w + fr) * 256 + ks * 32 + 8 * fq);
#pragma unroll 1
    for (int hf = 0; hf < 2; ++hf) {
        const int cb = 128 * hf;
#pragma unroll
        for (int i = 0; i < 8; ++i) { const int pi = tid + 512 * i, row = pi >> 5, cp = pi & 31;
            const u32x4 v = *(const u32x4*)(U + (size_t)(cb + row) * 256 + cp * 8);
            *(LAS u32x4*)(lds + SS_UL + row * SS_STRIDE + cp * 16) = v; }
        LBAR();
        {
#pragma unroll
            for (int m = 0; m < 8; ++m) {
                f32x4 acc = (f32x4){0.f, 0.f, 0.f, 0.f};
#pragma unroll
                for (int ks = 0; ks < 8; ++ks) { const bf16x8 af = *(const LAS bf16x8*)(lds + SS_UL + (16 * m + fr) * SS_STRIDE + ks * 64 + fq * 16);
                    acc = __builtin_amdgcn_mfma_f32_16x16x32_bf16(af, bfr[ks], acc, 0, 0, 0); }
#pragma unroll
                for (int r = 0; r < 4; ++r) *(LAS float*)(lds + SS_SL + (16 * m + 4 * fq + r) * SS_STRIDE + (16 * w + fr) * 4) = acc[r];
            }
        }
        LBAR();
        bf16x8 mfr[8];
#pragma unroll
        for (int ks = 0; ks < 8; ++ks) { const int kc = (2 * ks <= nt1) ? ks : 0;
            mfr[ks] = *(const bf16x8*)(Mg + (size_t)(16 * nt1 + fr) * 256 + kc * 32 + 8 * fq); }
        if (w == 0) {
            LAS unsigned char* srow = lds + SS_SL + lane * 8; LAS unsigned char* xrow = lds + SS_SL + lane * 4;
            f32x2 sv[8], svn[8];
#pragma unroll
            for (int j = 0; j < 8; ++j) sv[j] = *(const LAS f32x2*)(srow + j * SS_STRIDE);
#pragma unroll 1
            for (int c = 0; c < 128; c += 8) {
                const int cn = (c + 8 < 128) ? c + 8 : c;
#pragma unroll
                for (int j = 0; j < 8; ++j) svn[j] = *(const LAS f32x2*)(srow + (cn + j) * SS_STRIDE);
                asm volatile("" ::: "memory");
#pragma unroll
                for (int j = 0; j < 8; ++j) {
                    *(LAS unsigned*)(xrow + (c + j) * SS_STRIDE) = cvt_pk_bf16(x.x, x.y);
                    const f32x2 xs = {x.y, x.x};
                    x = lrr * x + (lii * xs + sv[j]);
                }
                asm volatile("" ::: "memory");
#pragma unroll
                for (int j = 0; j < 8; ++j) sv[j] = svn[j];
            }
        }
        LBAR();
        {
            f32x4 acc[8][2];
#pragma unroll
            for (int m = 0; m < 8; ++m) { acc[m][0] = (f32x4){0.f, 0.f, 0.f, 0.f}; acc[m][1] = (f32x4){0.f, 0.f, 0.f, 0.f}; }
#pragma unroll
            for (int ks = 0; ks < 4; ++ks) {
                const bf16x8 b0 = *(const bf16x8*)(Rg + (size_t)(16 * nt0 + fr) * 128 + ks * 32 + 8 * fq), b1 = *(const bf16x8*)(Rg + (size_t)(16 * nt1 + fr) * 128 + ks * 32 + 8 * fq);
#pragma unroll
                for (int m = 0; m < 8; ++m) { const bf16x8 af = *(const LAS bf16x8*)(lds + SS_SL + (16 * m + fr) * SS_STRIDE + ks * 64 + fq * 16);
                    acc[m][0] = __builtin_amdgcn_mfma_f32_16x16x32_bf16(af, b0, acc[m][0], 0, 0, 0); acc[m][1] = __builtin_amdgcn_mfma_f32_16x16x32_bf16(af, b1, acc[m][1], 0, 0, 0); }
            }
#pragma unroll
            for (int ks = 0; ks < 8; ++ks) {
                if (2 * ks <= nt1) {
                    const bool use0 = (2 * ks <= nt0);
                    const bf16x8 b1 = mfr[ks];
                    const bf16x8 b0 = *(const bf16x8*)(Mg + (size_t)(16 * nt0 + fr) * 256 + ks * 32 + 8 * fq);
#pragma unroll
                    for (int m = 0; m < 8; ++m) { const bf16x8 af = *(const LAS bf16x8*)(lds + SS_UL + (16 * m + fr) * SS_STRIDE + ks * 64 + fq * 16);
                        acc[m][1] = __builtin_amdgcn_mfma_f32_16x16x32_bf16(af, b1, acc[m][1], 0, 0, 0);
                        if (use0) acc[m][0] = __builtin_amdgcn_mfma_f32_16x16x32_bf16(af, b0, acc[m][0], 0, 0, 0); }
                }
            }
#pragma unroll
            for (int m = 0; m < 8; ++m)
#pragma unroll
                for (int j = 0; j < 2; ++j)
#pragma unroll
                    for (int r = 0; r < 4; ++r) { const int c = cb + 16 * m + 4 * fq + r, t = j ? nt1 : nt0;
                        const float v = acc[m][j][r];
                        const float o = v * sigm(1.5957691216f * (v + 0.044715f * v * v * v));
                        YG[(size_t)(16 * c + t) * 512 + fr] = (bf16_t)(cvt_pk_bf16(o, 0.f) & 0xffffu); }
        }
        LBAR();
    }
    __syncthreads();
}

constexpr int ATT_KS = 0, ATT_K_STRIDE = 272;
constexpr int ATT_VT = 256 * 272, ATT_V_STRIDE = 528;
static_assert(ATT_VT + 128 * ATT_V_STRIDE <= LDS_BYTES, "attention LDS");
__device__ __forceinline__ void attn_item(LAS unsigned char* lds, int b, int nb, int l, const Args& a, unsigned char* ws, int ssq_type = 2) {
    const int tid = opaque_tid(), lane = tid & 63, w = __builtin_amdgcn_readfirstlane(tid >> 6), fr = lane & 15, fq = lane >> 4;
    const bf16_t* Qg = (const bf16_t*)(ws + WS_Q); const bf16_t* Kg = (const bf16_t*)(ws + WS_K); const bf16_t* Vg = (const bf16_t*)(ws + WS_V);
    bf16_t* MIX = (bf16_t*)(ws + WS_MIX); ssq_t* ssq_att = ssq_ptr(ws, l, ssq_type);
    const int row0 = b * SEQ + nb * 128;
    const int krow0 = row0 - 128;
#pragma unroll
    for (int i = 0; i < 8; ++i) { const int pi = tid + i * 512, r = pi >> 4, cp = pi & 15;
        const bool ok = (nb > 0 || r >= 128);
        u32x4 v = *(const u32x4*)(Kg + (size_t)(ok ? krow0 + r : row0) * 128 + cp * 8);
        if (!ok) v = (u32x4){0u, 0u, 0u, 0u};
        *(LAS u32x4*)(lds + ATT_KS + r * ATT_K_STRIDE + cp * 16) = v; }
#pragma unroll
    for (int i = 0; i < 8; ++i) { const int pi = tid + i * 512, r = pi & 255, cp = pi >> 8;
        const bool ok = (nb > 0 || r >= 128);
        u32x4 v = *(const u32x4*)(Vg + (size_t)(ok ? krow0 + r : row0) * 128 + cp * 8);
        if (!ok) v = (u32x4){0u, 0u, 0u, 0u};
        LAS unsigned char* vb = lds + ATT_VT + (cp * 8) * ATT_V_STRIDE + r * 2;
        *(LAS bf16_t*)(vb + 0 * ATT_V_STRIDE) = (bf16_t)(v.x & 0xffffu); *(LAS bf16_t*)(vb + 1 * ATT_V_STRIDE) = (bf16_t)(v.x >> 16);
        *(LAS bf16_t*)(vb + 2 * ATT_V_STRIDE) = (bf16_t)(v.y & 0xffffu); *(LAS bf16_t*)(vb + 3 * ATT_V_STRIDE) = (bf16_t)(v.y >> 16);
        *(LAS bf16_t*)(vb + 4 * ATT_V_STRIDE) = (bf16_t)(v.z & 0xffffu); *(LAS bf16_t*)(vb + 5 * ATT_V_STRIDE) = (bf16_t)(v.z >> 16);
        *(LAS bf16_t*)(vb + 6 * ATT_V_STRIDE) = (bf16_t)(v.w & 0xffffu); *(LAS bf16_t*)(vb + 7 * ATT_V_STRIDE) = (bf16_t)(v.w >> 16); }
    __syncthreads();
    const int h = w, kvh = w >> 2;
    const float sink2 = a.in[I_SINK][l * 8 + h] * LOG2E;
    const float NEG = -__builtin_inff();
    bf16x8 qn0 = *(const bf16x8*)(Qg + (size_t)(row0 + fr) * 512 + h * 64 + 8 * fq), qn1 = *(const bf16x8*)(Qg + (size_t)(row0 + fr) * 512 + h * 64 + 32 + 8 * fq);
    for (int qt = 0; qt < 8; ++qt) {
        const bf16x8 q0 = qn0, q1 = qn1;
        if (qt < 7) { qn0 = *(const bf16x8*)(Qg + (size_t)(row0 + (qt + 1) * 16 + fr) * 512 + h * 64 + 8 * fq); qn1 = *(const bf16x8*)(Qg + (size_t)(row0 + (qt + 1) * 16 + fr) * 512 + h * 64 + 32 + 8 * fq); }
        f32x4 s[9];
#pragma unroll
        for (int i = 0; i < 9; ++i) {
            const LAS unsigned char* kp = lds + ATT_KS + (16 * (qt + i) + fr) * ATT_K_STRIDE + kvh * 128 + fq * 16;
            const bf16x8 k0 = *(const LAS bf16x8*)kp, k1 = *(const LAS bf16x8*)(kp + 64);
            f32x4 d = __builtin_amdgcn_mfma_f32_16x16x32_bf16(k0, q0, (f32x4){0.f, 0.f, 0.f, 0.f}, 0, 0, 0);
            s[i] = __builtin_amdgcn_mfma_f32_16x16x32_bf16(k1, q1, d, 0, 0, 0);
        }
#pragma unroll
        for (int r = 0; r < 4; ++r) { if (!(4 * fq + r > fr)) s[0][r] = NEG; if (!(4 * fq + r <= fr)) s[8][r] = NEG; }
        if (nb == 0) {
#pragma unroll
            for (int i = 0; i < 8; ++i) if (i < 8 - qt) s[i] = (f32x4){NEG, NEG, NEG, NEG};
        }
        float mx = sink2;
#pragma unroll
        for (int i = 0; i < 9; ++i) mx = fmaxf(mx, fmaxf(fmaxf(s[i][0], s[i][1]), fmaxf(s[i][2], s[i][3])));
        mx = fmaxf(mx, __shfl_xor(mx, 16)); mx = fmaxf(mx, __shfl_xor(mx, 32));
        float sum = 0.f;
#pragma unroll
        for (int i = 0; i < 9; ++i)
#pragma unroll
            for (int r = 0; r < 4; ++r) { const float e = __builtin_amdgcn_exp2f(s[i][r] - mx); s[i][r] = e; sum += e; }
        sum += __shfl_xor(sum, 16); sum += __shfl_xor(sum, 32);
        sum += __builtin_amdgcn_exp2f(sink2 - mx);
        const float inv = __builtin_amdgcn_rcpf(sum);
        f32x4 o[4];
#pragma unroll
        for (int dt = 0; dt < 4; ++dt) o[dt] = (f32x4){0.f, 0.f, 0.f, 0.f};
#pragma unroll
        for (int i = 0; i < 8; i += 2) {
            u32x4 pw; pw.x = cvt_pk_bf16(s[i][0], s[i][1]); pw.y = cvt_pk_bf16(s[i][2], s[i][3]); pw.z = cvt_pk_bf16(s[i + 1][0], s[i + 1][1]); pw.w = cvt_pk_bf16(s[i + 1][2], s[i + 1][3]);
            const bf16x8 pb = __builtin_bit_cast(bf16x8, pw);
#pragma unroll
            for (int dt = 0; dt < 4; ++dt) {
                const LAS unsigned char* vp = lds + ATT_VT + (kvh * 64 + dt * 16 + fr) * ATT_V_STRIDE + (16 * (qt + i) + 4 * fq) * 2;
                const u32x2 va = *(const LAS u32x2*)vp, vb = *(const LAS u32x2*)(vp + 32);
                u32x4 vw; vw.x = va.x; vw.y = va.y; vw.z = vb.x; vw.w = vb.y;
                o[dt] = __builtin_amdgcn_mfma_f32_16x16x32_bf16(__builtin_bit_cast(bf16x8, vw), pb, o[dt], 0, 0, 0);
            }
        }
        {
            u32x2 pw; pw.x = cvt_pk_bf16(s[8][0], s[8][1]); pw.y = cvt_pk_bf16(s[8][2], s[8][3]);
            const bf16x4 pb = __builtin_bit_cast(bf16x4, pw);
#pragma unroll
            for (int dt = 0; dt < 4; ++dt) {
                const LAS unsigned char* vp = lds + ATT_VT + (kvh * 64 + dt * 16 + fr) * ATT_V_STRIDE + (16 * (qt + 8) + 4 * fq) * 2;
                const u32x2 va = *(const LAS u32x2*)vp;
                o[dt] = __builtin_amdgcn_mfma_f32_16x16x16bf16_1k(__builtin_bit_cast(bf16x4, va), pb, o[dt], 0, 0, 0);
            }
        }
        const int row = row0 + qt * 16 + fr; float part = 0.f;
#pragma unroll
        for (int dt = 0; dt < 4; ++dt) { const f32x4 v = o[dt] * inv; part += (v[0] * v[0] + v[1] * v[1]) + (v[2] * v[2] + v[3] * v[3]);
            u32x2 wv; wv.x = cvt_pk_bf16(v[0], v[1]); wv.y = cvt_pk_bf16(v[2], v[3]);
            *(u32x2*)(MIX + (size_t)row * 1024 + 512 + h * 64 + dt * 16 + 4 * fq) = wv; }
        part += __shfl_xor(part, 16); part += __shfl_xor(part, 32);
        if (fq == 0) ssq_add(ssq_att + row, part);
    }
    __syncthreads();
}

#define XB_TMO      128
#define XB_XCNT(j)  (256  + 64 * (j))
#define XB_XSUB(j)  (1280 + 64 * (j))
#define XB_XGEN(j)  (2304 + 64 * (j))
#define XB_TOP      3328
#define XB_TOPGEN   3392
#define XCD_BAR_WORDS 3456
#define XB_SPIN_CAP (1u << 20)
__device__ __forceinline__ unsigned xb_ld(unsigned* p)              { return __hip_atomic_load(p, __ATOMIC_RELAXED, __HIP_MEMORY_SCOPE_AGENT); }
__device__ __forceinline__ unsigned xb_add(unsigned* p, unsigned v) { return __hip_atomic_fetch_add(p, v, __ATOMIC_RELAXED, __HIP_MEMORY_SCOPE_AGENT); }
__device__ __forceinline__ unsigned xb_xcc_id() { return (unsigned)__builtin_amdgcn_s_getreg((3 << 11) | 20) & 0xFu; }
#define XB_SPIN(cond, bar) do { unsigned _sp = 0; while (cond) { __builtin_amdgcn_s_sleep(1); \
    if ((++_sp & 255u) == 0u) { if (xb_ld(&(bar)[XB_TMO])) break; if (_sp > XB_SPIN_CAP) { atomicAdd(&(bar)[XB_TMO], 1u); break; } } } } while (0)
struct XcdBarrier { unsigned* bar; unsigned x; volatile LAS unsigned* st; };
__device__ __forceinline__ XcdBarrier xcd_barrier_post(unsigned* bar, volatile LAS unsigned* st) {
    XcdBarrier b; b.bar = bar; b.x = xb_xcc_id(); b.st = st;
    if (threadIdx.x == 0) (void)xb_add(&bar[XB_XCNT(b.x)], 1u);
    return b;
}
__device__ __forceinline__ void xcd_barrier_complete(unsigned* bar, unsigned x, unsigned& nloc, unsigned& nx) {
    const unsigned G = gridDim.x * gridDim.y * gridDim.z;
    unsigned sum, cnt, mine, sp = 0u;
    for (;;) {
        sum = 0u; cnt = 0u; mine = 0u;
#pragma unroll
        for (unsigned j = 0; j < 16; ++j) { const unsigned c = xb_ld(&bar[XB_XCNT(j)]); sum += c; cnt += (c > 0u) ? 1u : 0u; mine = (j == x) ? c : mine; }
        if (sum == G) break;
        __builtin_amdgcn_s_sleep(1);
        if ((++sp & 255u) == 0u) { if (xb_ld(&bar[XB_TMO])) break; if (sp > XB_SPIN_CAP) { atomicAdd(&bar[XB_TMO], 1u); break; } }
    }
    nloc = mine > 0u ? mine : 1u; nx = cnt > 0u ? cnt : 1u;
}
__device__ __forceinline__ void xcd_barrier(const XcdBarrier& b) {
    asm volatile("s_waitcnt vmcnt(0)" ::: "memory");
    __syncthreads();
    if (threadIdx.x == 0) {
        unsigned* bar = b.bar;
        __builtin_amdgcn_s_waitcnt(0);
        unsigned nloc = b.st[0], nx = b.st[1];
        if (nloc == 0u) { xcd_barrier_complete(bar, b.x, nloc, nx); b.st[0] = nloc; b.st[1] = nx; }
        const unsigned old = xb_add(&bar[XB_XSUB(b.x)], 1u);
        const unsigned gen = old / nloc;
        if (old + 1u == (gen + 1u) * nloc) {
            __builtin_amdgcn_fence(__ATOMIC_RELEASE, "agent");
            asm volatile("s_waitcnt vmcnt(0)" ::: "memory");
            const unsigned og = xb_add(&bar[XB_TOP], 1u);
            const unsigned tg = og / nx;
            if (og + 1u == (tg + 1u) * nx) xb_add(&bar[XB_TOPGEN], 1u);
            else XB_SPIN(xb_ld(&bar[XB_TOPGEN]) == tg, bar);
            __builtin_amdgcn_fence(__ATOMIC_ACQUIRE, "agent");
            xb_add(&bar[XB_XGEN(b.x)], 1u);
            asm volatile("s_waitcnt vmcnt(0)" ::: "memory");
        } else {
            XB_SPIN(xb_ld(&bar[XB_XGEN(b.x)]) == gen, bar);
            __builtin_amdgcn_fence(__ATOMIC_ACQUIRE, "agent");
            asm volatile("s_waitcnt vmcnt(0)" ::: "memory");
        }
    }
    __syncthreads();
}

__device__ __forceinline__ const LAS float* build_rstd_tab(LAS unsigned char* lds, const pg8::StaticOrder& S, const ssq_t* ssq) {
    pg8::Unit uu; if (S.next(15, uu)) return nullptr;
    LAS float* tab = (LAS float*)(lds + LDS_FAC_OFF);
    const int t = opaque_tid();
    for (int i = t >> 8; S.next(i, uu); i += 2) tab[i * 256 + (t & 255)] = rsqrtf(ssq_get(ssq + uu.pm * 256 + (t & 255)) * (1.f / 1024.f) + EPS);
    __syncthreads();
    return tab;
}

__global__ void __launch_bounds__(512, 2) hymba_fwd(Args a_in) {
    extern __shared__ __attribute__((aligned(16))) unsigned char lds_raw[];
    LAS unsigned char* lds = (LAS unsigned char*)lds_raw;
    const int G = gridDim.x, bx = blockIdx.x;
    int ph = a_in.ph_lo; const int ph_hi = a_in.ph_hi;
    volatile LAS unsigned* bst = (volatile LAS unsigned*)(lds + LDS_BAR_OFF);
    if (threadIdx.x < 2) bst[threadIdx.x] = 0u;
    __syncthreads();
#if MK_MULTI
    const XcdBarrier xbar = xcd_barrier_post((unsigned*)(a_in.ws + WS_CTL), bst);
#endif
    if (ph == 0) {
#if !MK_MULTI
        if (bx == 0) { unsigned* bw = (unsigned*)(a_in.ws + WS_CTL); for (int i = threadIdx.x; i < XCD_BAR_WORDS; i += 512) bw[i] = 0u; }
#endif
        if (PH_EN(9)) for (int rep = 0; rep < 1 + ((PROBE_REP >> 2) & 1); ++rep) { prologue(a_in, lds, a_in.ws); __syncthreads(); }
        __syncthreads(); ++ph;
        if (ph < ph_hi) cg::this_grid().sync();
    }
#if !MK_MULTI
    const XcdBarrier xbar = xcd_barrier_post((unsigned*)(a_in.ws + WS_CTL), bst);
#endif
    for (; ph < ph_hi && ph < NPHASE - 1; ++ph) {
        const Args& a = a_in;
        size_t zoff = 0; asm volatile("" : "+s"(zoff));
        unsigned char* ws = a.ws + zoff;
        bf16_t* HB1 = (bf16_t*)a.out + zoff; bf16_t* HB0 = (bf16_t*)(ws + WS_HB);
        const int l = (ph - 1) / 7, j = (ph - 1) % 7;
        unsigned char* wl = ws + WS_W + (size_t)l * W_LAYER;
        pg8::StaticOrder S;
        if (j == 0) { if (PH_EN(0)) {
            pg8::Gemm g{HB0, (const bf16_t*)(wl + WO_IN), MTOK, INW, DM}; S.init(MTOK, INW, G, bx);
            pg8::EpiInProj E{ssq_ptr(ws, l, 0), (bf16_t*)(ws + WS_UG), (bf16_t*)(ws + WS_Q), (bf16_t*)(ws + WS_K), (bf16_t*)(ws + WS_V), build_rstd_tab(lds, S, ssq_ptr(ws, l, 0))};
            pg8::gemm_phase(lds, g, S, E);
            if (PH_EN(4) && G == 256) { pg8::Gemm g2{(const bf16_t*)(ws + WS_PB) + (size_t)l * MTOK * PLE, (const bf16_t*)(wl + WO_P), MTOK, DM, PLE};
              pg8::StaticOrder S2; S2.init(MTOK, DM, 128, bx >= 128 ? bx - 128 : (1 << 20));
              pg8::EpiPlain E2{(bf16_t*)(ws + WS_PP)};
              pg8::gemm_phase(lds, g2, S2, E2); } }
        } else if (j == 1) {
            if (PH_EN(1)) for (int rep = 0; rep < 1 + (PROBE_REP & 1); ++rep) for (int it = bx; it < BATCH * NG; it += G) ssm_item(lds, it >> 5, it & 31, l, a, ws);
            if (PH_EN(2)) for (int rep = 0; rep < 1 + ((PROBE_REP >> 1) & 1); ++rep) for (int it = bx; it < BATCH * (SEQ / 128); it += G) attn_item(lds, it >> 5, it & 31, l, a, ws, rep ? 5 : 2);
        } else if (j == 2) {
            if (PH_EN(3)) { pg8::Gemm g{(const bf16_t*)(ws + WS_YG), (const bf16_t*)(wl + WO_GLU), MTOK, SSMW, SSMW}; S.init(MTOK, SSMW, G, bx);
              pg8::EpiGlu E{(const bf16_t*)(ws + WS_YG), (bf16_t*)(ws + WS_MIX), ssq_ptr(ws, l, 1)};
              pg8::gemm_phase(lds, g, S, E); }
            if (PH_EN(4) && G != 256) { pg8::Gemm g{(const bf16_t*)(ws + WS_PB) + (size_t)l * MTOK * PLE, (const bf16_t*)(wl + WO_P), MTOK, DM, PLE}; S.init(MTOK, DM, G, bx);
              pg8::EpiPlain E{(bf16_t*)(ws + WS_PP)};
              pg8::gemm_phase(lds, g, S, E); }
        } else if (j == 3) { if (PH_EN(5)) {
            pg8::Gemm g{(const bf16_t*)(ws + WS_MIX), (const bf16_t*)(wl + WO_OUT), MTOK, DM, DM}; S.init(MTOK, DM, G, bx);
            LAS f32x2* fac = (LAS f32x2*)(lds + LDS_FAC_OFF);
            { const int t2 = opaque_tid(); const ssq_t* sa = ssq_ptr(ws, l, 1); const ssq_t* sb = ssq_ptr(ws, l, 2); pg8::Unit uu;
              for (int i = 0; i < 4 && S.next(i, uu); ++i) if (t2 < 256) { const int row = uu.pm * 256 + t2;
                  const float rs_s = rsqrtf(ssq_get(sa + row) * (1.f / 512.f) + EPS), rs_a = rsqrtf(ssq_get(sb + row) * (1.f / 512.f) + EPS); fac[i * 256 + t2] = (f32x2){rs_s / rs_a, rs_a}; }
              __syncthreads(); }
            pg8::EpiRes<1> E{HB0, HB1, ssq_ptr(ws, l, 3), nullptr, nullptr, fac, nullptr};
            pg8::gemm_phase(lds, g, S, E); }
        } else if (j == 4) { if (PH_EN(6)) {
            pg8::Gemm g{HB1, (const bf16_t*)(wl + WO_FI), MTOK, 2 * FFH, DM}; S.init(MTOK, 2 * FFH, G, bx);
            pg8::EpiFfnIn E{ssq_ptr(ws, l, 3), (bf16_t*)(ws + WS_HID), build_rstd_tab(lds, S, ssq_ptr(ws, l, 3))};
            for (int rep = 0; rep < 1 + ((PROBE_REP >> 4) & 1); ++rep) pg8::gemm_phase(lds, g, S, E); }
        } else if (j == 5) { if (PH_EN(7)) {
            pg8::Gemm g{(const bf16_t*)(ws + WS_HID), (const bf16_t*)(wl + WO_FO), MTOK, DM, FFH}; S.init(MTOK, DM, G, bx);
            pg8::EpiRes<0> E{HB1, HB1, ssq_ptr(ws, l, 4), nullptr, nullptr, nullptr, nullptr};
            pg8::gemm_phase(lds, g, S, E); }
        } else { if (PH_EN(8)) {
            pg8::Gemm g{HB1, (const bf16_t*)(wl + WO_G), MTOK, DM, DM}; S.init(MTOK, DM, G, bx);
            ssq_t* nxt = (l + 1 < DEPTH) ? ssq_ptr(ws, l + 1, 0) : ssq_ptr(ws, 0, 1);
            pg8::EpiRes<2> E{HB1, HB0, nxt, ssq_ptr(ws, l, 4), (const bf16_t*)(ws + WS_PP), nullptr, build_rstd_tab(lds, S, ssq_ptr(ws, l, 4))};
            pg8::gemm_phase(lds, g, S, E); }
        }
        if (ph + 1 < ph_hi) { xcd_barrier(xbar); if (PROBE_REP & 8) xcd_barrier(xbar); }
    }
    if (ph == NPHASE - 1 && ph < ph_hi) { if (PH_EN(10)) {
        float* O = a_in.out; const bf16_t* HB0 = (const bf16_t*)(a_in.ws + WS_HB);
        const int tid = opaque_tid(), lane = tid & 63, gw = bx * 8 + (tid >> 6), NGW = G * 8;
        const f32x4* gf = (const f32x4*)a_in.in[I_NFIN] + 2 * lane;
        for (int m = gw; m < MTOK; m += 2 * NGW) {
            const int m2 = (m + NGW < MTOK) ? m + NGW : m;
            const u32x4* hr = (const u32x4*)(HB0 + (size_t)m * DM) + lane; const u32x4* hr2 = (const u32x4*)(HB0 + (size_t)m2 * DM) + lane;
            u32x4 wv[2][2];
#pragma unroll
            for (int j = 0; j < 2; ++j) { wv[0][j] = hr[64 * j]; wv[1][j] = hr2[64 * j]; }
#pragma unroll
            for (int q = 0; q < 2; ++q) { const int mr = q ? m2 : m; f32x4* orow = (f32x4*)(O + (size_t)mr * DM) + 2 * lane; float v[2][8]; float s = 0.f;
#pragma unroll
                for (int j = 0; j < 2; ++j) { const u32x4 w = wv[q][j]; v[j][0] = bflo(w.x); v[j][1] = bfhi(w.x); v[j][2] = bflo(w.y); v[j][3] = bfhi(w.y); v[j][4] = bflo(w.z); v[j][5] = bfhi(w.z); v[j][6] = bflo(w.w); v[j][7] = bfhi(w.w);
#pragma unroll
                    for (int k = 0; k < 8; ++k) s += v[j][k] * v[j][k]; }
                const float rs = rsqrtf(wave_sum(s) * (1.f / DM) + EPS);
                if (q == 0 || m2 != m) {
#pragma unroll
                for (int j = 0; j < 2; ++j) { const f32x4 g0 = gf[128 * j], g1 = gf[128 * j + 1];
                    orow[128 * j] = (f32x4){v[j][0] * rs * g0[0], v[j][1] * rs * g0[1], v[j][2] * rs * g0[2], v[j][3] * rs * g0[3]};
                    orow[128 * j + 1] = (f32x4){v[j][4] * rs * g1[0], v[j][5] * rs * g1[1], v[j][6] * rs * g1[2], v[j][7] * rs * g1[3]}; } } } } }
    }
}

extern "C" void kernel_launch(void* const* d_in, const int* in_sizes, int n_in, void* d_out, int out_size, void* d_ws, size_t ws_size, hipStream_t stream) {
    static int grid = 0;
    if (grid == 0) {
        if (n_in != 24 || out_size != MTOK * DM || ws_size < WS_END) { fprintf(stderr, "kernel_launch: unexpected problem: n_in %d out %d ws %zu\n", n_in, out_size, ws_size); grid = -1; return; }
        int dev = 0, cus = 0, per_cu = 0;
        (void)hipGetDevice(&dev); (void)hipDeviceGetAttribute(&cus, hipDeviceAttributeMultiprocessorCount, dev);
        if (hipFuncSetAttribute((const void*)hymba_fwd, hipFuncAttributeMaxDynamicSharedMemorySize, LDS_BYTES) != hipSuccess) { fprintf(stderr, "kernel_launch: hipFuncSetAttribute failed\n"); grid = -1; return; }
        if (hipOccupancyMaxActiveBlocksPerMultiprocessor(&per_cu, (const void*)hymba_fwd, 512, LDS_BYTES) != hipSuccess || per_cu < 1) { fprintf(stderr, "kernel_launch: occupancy query says %d\n", per_cu); per_cu = 1; }
        (void)hipGetLastError();
        grid = cus * 1;
        if (grid < 128) { fprintf(stderr, "kernel_launch: needs >= 128 CUs (phase D's factor table holds 4 units per workgroup), got %d\n", grid); grid = -1; return; }
        fprintf(stderr, "kernel_launch: cus %d per_cu %d grid %d\n", cus, per_cu, grid);
    }
    if (grid < 0) return;
#if MK_MULTI
    if (hipMemsetAsync((char*)d_ws + WS_CTL, 0, CTL_ZERO_BYTES, stream) != hipSuccess) { fprintf(stderr, "kernel_launch: memset of the barrier words failed\n"); return; }
#endif
    Args a{};
    for (int i = 0; i < 24; ++i) a.in[i] = (const float*)d_in[i];
    a.out = (float*)d_out; a.ws = (unsigned char*)d_ws;
#if MK_MULTI
    for (int ph = 0; ph < NPHASE; ++ph) { a.ph_lo = ph; a.ph_hi = ph + 1; hipLaunchKernelGGL(hymba_fwd, dim3(grid), dim3(512), LDS_BYTES, stream, a); }
#else
    a.ph_lo = 0; a.ph_hi = NPHASE;
    void* args[] = {&a};
    hipError_t e = hipLaunchCooperativeKernel((const void*)hymba_fwd, dim3(grid), dim3(512), args, LDS_BYTES, stream);
    if (e != hipSuccess) fprintf(stderr, "kernel_launch: cooperative launch failed: %s (grid %d)\n", hipGetErrorString(e), grid);
#endif
}
```
